# Optimizing an MI355X kernel written in HIP

```python
import jax, jax.numpy as jnp
from jax import lax
import numpy as np

D_MODEL = 2048
BATCH = 2
SEQ = 16384
DEPTH = 2
DEC_BATCH = 8
DEC_SEQ = 64
PAST_LEN = 1024

CHUNK = 64
GMLP_CHUNK = 128
D_MIX = D_MODEL
D_A = D_MIX // 2
D_B = D_MIX - D_A
H_A = 8
HD_A = D_A // H_A
H_B = 8
CONV_K = 3
D_FF = 5632
D_IN = 2 * D_A + 3 * D_B
EPS = 1e-6

kernel_name = "hybrid_gmlp_shortconv_streaming_step"


def _rmsnorm(x, g):
    xf = x.astype(jnp.float32)
    y = xf * lax.rsqrt(jnp.mean(xf * xf, axis=-1, keepdims=True) + EPS)
    return (y * g.astype(jnp.float32)).astype(x.dtype)


def _causal_dwconv(x, prev, w):
    t = x.shape[1]
    xp = jnp.concatenate([prev.astype(x.dtype), x], axis=1)
    w = w.astype(x.dtype)
    y = w[0] * xp[:, 0:t]
    for k in range(1, CONV_K):
        y = y + w[k] * xp[:, k:k + t]
    return y, xp[:, -(CONV_K - 1):]


def _gmlp_spatial(u, v, ws, bs):
    b, t, _ = v.shape
    n = -(-t // GMLP_CHUNK)
    pad = n * GMLP_CHUNK - t
    vp = jnp.pad(v, ((0, 0), (0, pad), (0, 0))).reshape(b, n, GMLP_CHUNK, H_A, HD_A)
    blk = jnp.arange(GMLP_CHUNK) // CHUNK
    mask = blk[:, None] >= blk[None, :]
    wm = jnp.where(mask[None], ws, 0.0).astype(v.dtype)
    z = jnp.einsum('hts,bnshd->bnthd', wm, vp)
    z = z + jnp.transpose(bs).astype(v.dtype)[None, None, :, :, None]
    z = z.reshape(b, n * GMLP_CHUNK, D_A)[:, :t]
    return u * z


def _layer(x, sconv_prev, ffn_prev, n1_g, w_in, vnorm_g, ws, bs, sconv_w,
           onorm_a_g, onorm_b_g, w_out, n2_g, ffn_up, ffn_conv_w, ffn_down):
    bsz, t, _ = x.shape
    h = _rmsnorm(x, n1_g)
    proj = h @ w_in.astype(x.dtype)
    u, v, gb, gc, hin = jnp.split(
        proj, [D_A, 2 * D_A, 2 * D_A + D_B, 2 * D_A + 2 * D_B], axis=-1)
    u = jax.nn.gelu(u)
    v = _rmsnorm(jax.nn.gelu(v).reshape(bsz, t, H_A, HD_A),
                 vnorm_g.reshape(H_A, HD_A)).reshape(bsz, t, D_A)
    a = _gmlp_spatial(u, v, ws, bs)
    cb, sconv_new = _causal_dwconv(gc * hin, sconv_prev, sconv_w)
    bout = gb * cb
    mix = jnp.concatenate([_rmsnorm(a, onorm_a_g), _rmsnorm(bout, onorm_b_g)], axis=-1)
    x = x + mix @ w_out.astype(x.dtype)
    h2 = _rmsnorm(x, n2_g)
    up, ffn_new = _causal_dwconv(h2 @ ffn_up.astype(x.dtype), ffn_prev, ffn_conv_w)
    g, val = jnp.split(up, 2, axis=-1)
    x = x + (jax.nn.silu(g) * val) @ ffn_down.astype(x.dtype)
    return x, v, sconv_new, ffn_new


def setup_inputs(seed: int = 0) -> dict:
    key = jax.random.key(seed)
    ks = jax.random.split(key, 20)
    nrm = jax.random.normal
    f32 = jnp.float32
    return {
        "x_prompt": nrm(ks[0], (BATCH, SEQ, D_MODEL), f32),
        "x_sample": nrm(ks[1], (DEC_BATCH, DEC_SEQ, D_MODEL), f32),
        "state_sconv": nrm(ks[2], (DEPTH, DEC_BATCH, CONV_K - 1, D_B), f32),
        "state_ffnconv": nrm(ks[3], (DEPTH, DEC_BATCH, CONV_K - 1, 2 * D_FF), f32),
        "n1_g": 1.0 + 0.02 * nrm(ks[4], (DEPTH, D_MODEL), f32),
        "w_in": nrm(ks[5], (DEPTH, D_MODEL, D_IN), f32) * D_MODEL ** -0.5,
        "vnorm_g": 1.0 + 0.02 * nrm(ks[6], (DEPTH, D_A), f32),
        "gmlp_ws": nrm(ks[7], (DEPTH, H_A, GMLP_CHUNK, GMLP_CHUNK), f32) * GMLP_CHUNK ** -0.5,
        "gmlp_bs": 1.0 + 0.02 * nrm(ks[8], (DEPTH, H_A, GMLP_CHUNK), f32),
        "sconv_w": nrm(ks[9], (DEPTH, CONV_K, D_B), f32) * CONV_K ** -0.5,
        "onorm_a_g": 1.0 + 0.02 * nrm(ks[10], (DEPTH, D_A), f32),
        "onorm_b_g": 1.0 + 0.02 * nrm(ks[11], (DEPTH, D_B), f32),
        "w_out": nrm(ks[12], (DEPTH, D_MIX, D_MODEL), f32) * D_MIX ** -0.5,
        "n2_g": 1.0 + 0.02 * nrm(ks[13], (DEPTH, D_MODEL), f32),
        "ffn_up": nrm(ks[14], (DEPTH, D_MODEL, 2 * D_FF), f32) * D_MODEL ** -0.5,
        "ffn_conv_w": nrm(ks[15], (DEPTH, CONV_K, 2 * D_FF), f32) * CONV_K ** -0.5,
        "ffn_down": nrm(ks[16], (DEPTH, D_FF, D_MODEL), f32) * D_FF ** -0.5,
        "final_g": 1.0 + 0.02 * nrm(ks[17], (D_MODEL,), f32),
    }


def reference(x_prompt, x_sample, state_sconv, state_ffnconv, n1_g, w_in, vnorm_g,
              gmlp_ws, gmlp_bs, sconv_w, onorm_a_g, onorm_b_g, w_out, n2_g,
              ffn_up, ffn_conv_w, ffn_down, final_g):
    xp = x_prompt
    xs = x_sample
    p_sconv, p_ffn, s_v, s_sconv, s_ffn = [], [], [], [], []
    for l in range(DEPTH):
        w = (n1_g[l], w_in[l], vnorm_g[l], gmlp_ws[l], gmlp_bs[l], sconv_w[l],
             onorm_a_g[l], onorm_b_g[l], w_out[l], n2_g[l], ffn_up[l],
             ffn_conv_w[l], ffn_down[l])
        zs = jnp.zeros((xp.shape[0], CONV_K - 1, D_B), xp.dtype)
        zf = jnp.zeros((xp.shape[0], CONV_K - 1, 2 * D_FF), xp.dtype)
        xp, _, ps, pf = _layer(xp, zs, zf, *w)
        p_sconv.append(ps)
        p_ffn.append(pf)
        xs, sv, ss, sf = _layer(xs, state_sconv[l], state_ffnconv[l], *w)
        s_v.append(sv)
        s_sconv.append(ss)
        s_ffn.append(sf)
    y_prompt = _rmsnorm(xp, final_g)
    y_sample = _rmsnorm(xs, final_g)
    return (y_prompt, y_sample, jnp.stack(p_sconv), jnp.stack(p_ffn),
            jnp.stack(s_v), jnp.stack(s_sconv), jnp.stack(s_ffn))
```

```cpp
#include <hip/hip_runtime.h>
#include <hip/hip_cooperative_groups.h>
#include <cstdio>
namespace cg = cooperative_groups;
namespace pg8 {
#define PG8_LAS __attribute__((address_space(3)))
typedef unsigned short bf16_t;
typedef short bf16x8 __attribute__((ext_vector_type(8)));
typedef float f32x4 __attribute__((ext_vector_type(4)));
typedef unsigned u32x4 __attribute__((ext_vector_type(4)));
constexpr int BM = 256, BK = 64, HALF = 128, HTB = HALF * BK * 2  , STAGE_BYTES = 8 * HTB, NXCD = 8, WGM = 8;

__host__ __device__ __forceinline__ int lds_byte(int r, int c) { const int st = (r >> 4) * 2 + (c >> 5), rr = r & 15, cc = c & 31, ob = rr * 64 + cc * 2; return st * 1024 + (ob ^ (((ob >> 9) & 1) << 5)); }
__host__ __device__ __forceinline__ void stage_rc(int b, int& R, int& C) { const int st = b / 1024, sb = b % 1024, swz = sb ^ (((sb >> 9) & 1) << 5); R = (st >> 1) * 16 + swz / 64; C = (st & 1) * 32 + (swz % 64) / 2; }
__host__ __device__ __forceinline__ int perm32(int rho) { const int n = rho >> 4, i = rho & 15; return 8 * (i >> 2) + 4 * n + (i & 3); }

struct Unit { int pm, pn; };
struct Gemm { const bf16_t* A; const bf16_t* Bt; int M, N, K; };

struct StaticOrder {
    int nM, nN, nwg, G, c;
    __host__ __device__ void init(int M, int N, int G_, int c_) { nM = M / BM; nN = N / BM; nwg = nM * nN; G = G_; c = c_; }
    __host__ __device__ bool next(int i, Unit& u) const {
        const long L = (long)i * G + c; if (L >= nwg) return false;
        int wgid = (int)L; { const int q = nwg / NXCD, r = nwg % NXCD, xcd = wgid % NXCD, off = wgid / NXCD; wgid = (xcd < r ? xcd * (q + 1) : r * (q + 1) + (xcd - r) * q) + off; }
        const int nig = WGM * nN, gid = wgid / nig, fm = gid * WGM, gsz = (nM - fm) < WGM ? (nM - fm) : WGM;
        u.pm = fm + ((wgid % nig) % gsz); u.pn = (wgid % nig) / gsz; return true;
    }
    __device__ __forceinline__ void a_ready(const Unit&) const {}
    __device__ __forceinline__ void done(const Unit&) const {}
};
__device__ __forceinline__ unsigned cvt_pk_bf16(float lo, float hi) { unsigned r; asm volatile("v_cvt_pk_bf16_f32 %0, %1, %2" : "=v"(r) : "v"(lo), "v"(hi)); return r; }
typedef float f32x2 __attribute__((ext_vector_type(2)));

constexpr int DM = 2048, MROWS = 33280, NPROMPT = 32768, DIN = 5120, DFF = 5632, DUP = 11264, DA = 1024;
constexpr float EPS = 1e-6f;
typedef unsigned u32x2 __attribute__((ext_vector_type(2)));
__device__ __forceinline__ float rs_of(float ss, float invn) { return __builtin_amdgcn_rsqf(ss * invn + EPS); }
__device__ __forceinline__ float bf_lo(unsigned w) { return __uint_as_float(w << 16); }
__device__ __forceinline__ float bf_hi(unsigned w) { return __uint_as_float(w & 0xffff0000u); }
__device__ __forceinline__ float sigmoidf_fast(float x) { return __builtin_amdgcn_rcpf(1.0f + __builtin_amdgcn_exp2f(-1.44269504089f * x)); }
__device__ __forceinline__ float gelu_tanh(float x) { const float u = 1.5957691216f * x * (1.0f + 0.044715f * x * x); return x * sigmoidf_fast(u); }
template <int CTRL> __device__ __forceinline__ float dpp_f(float old, float src) {
    return __builtin_bit_cast(float, __builtin_amdgcn_update_dpp(__builtin_bit_cast(int, old), __builtin_bit_cast(int, src), CTRL, 0xf, 0xf, false)); }

struct EpiProj {
    static constexpr bool PERM = true, AFTER_DRAIN = false;
    bf16_t* O; const float* ss;
    __device__ __forceinline__ void operator()(const f32x4 (&acc)[2][2][4][2], const Unit& u, int wr, int wc, int fr, int fq) const {
        const int row0 = u.pm * BM + wr * 64 + fr, col0 = u.pn * BM + wc * 32 + 8 * fq;
#pragma unroll
        for (int ai = 0; ai < 2; ++ai)
#pragma unroll
            for (int m = 0; m < 4; ++m) { const int r = row0 + ai * HALF + m * 16; const float rs = rs_of(ss[r], 1.0f / DM);
                bf16_t* rowp = O + (size_t)r * DIN + col0;
#pragma unroll
                for (int bj = 0; bj < 2; ++bj) { const f32x4 v0 = acc[ai][bj][m][0] * rs, v1 = acc[ai][bj][m][1] * rs;
                    u32x4 w; w.x = cvt_pk_bf16(v0[0], v0[1]); w.y = cvt_pk_bf16(v0[2], v0[3]); w.z = cvt_pk_bf16(v1[0], v1[1]); w.w = cvt_pk_bf16(v1[2], v1[3]);
                    *(u32x4*)(rowp + bj * HALF) = w; } }
    }
};
struct EpiResid {
    static constexpr bool PERM = false, AFTER_DRAIN = false;
    const float* baseP; const float* baseS; float* out; bf16_t* xb; float* ssout;
    __device__ __forceinline__ void operator()(const f32x4 (&acc)[2][2][4][2], const Unit& u, int wr, int wc, int fr, int fq) const {
        const int row0 = u.pm * BM + wr * 64 + fr, col0 = u.pn * BM + wc * 32 + 4 * fq;
#pragma unroll
        for (int ai = 0; ai < 2; ++ai)
#pragma unroll
            for (int m = 0; m < 4; ++m) { const int r = row0 + ai * HALF + m * 16;
                const float* bp = (r < NPROMPT ? baseP + (size_t)r * DM : baseS + (size_t)(r - NPROMPT) * DM) + col0;
                float* op = out + (size_t)r * DM + col0; float s = 0.f;
#pragma unroll
                for (int bj = 0; bj < 2; ++bj)
#pragma unroll
                    for (int n = 0; n < 2; ++n) { const f32x4 o = *(const f32x4*)(bp + bj * HALF + n * 16) + acc[ai][bj][m][n];
                        *(f32x4*)(op + bj * HALF + n * 16) = o; s += (o[0] * o[0] + o[1] * o[1]) + (o[2] * o[2] + o[3] * o[3]);
                        if (xb) { u32x2 w; w.x = cvt_pk_bf16(o[0], o[1]); w.y = cvt_pk_bf16(o[2], o[3]); *(u32x2*)(xb + (size_t)r * DM + col0 + bj * HALF + n * 16) = w; } }
                s += __shfl_xor(s, 16); s += __shfl_xor(s, 32);
                if (fq == 0) unsafeAtomicAdd(ssout + r, s);
                asm volatile("" ::: "memory"); }
    }
};
struct EpiFfn {
    static constexpr bool PERM = true, AFTER_DRAIN = false;
    bf16_t* act; const float* ss; const float* cw; float* sb;
    __device__ __forceinline__ void operator()(const f32x4 (&acc)[2][2][4][2], const Unit& u, int wr, int wc, int fr, int fq) const {
        const int rt0 = wr * 64 + fr, gc0 = u.pn * 128 + wc * 32 + 8 * fq;
#pragma unroll
        for (int ai = 0; ai < 2; ++ai) {
            float rsv[4];
#pragma unroll
            for (int m = 0; m < 4; ++m) rsv[m] = rs_of(ss[u.pm * BM + rt0 + ai * HALF + m * 16], 1.0f / DM);
            const int blk = u.pm * 4 + ai * 2 + wr;
#pragma unroll
            for (int n = 0; n < 2; ++n) { const int gc = gc0 + 4 * n;
                const f32x4 wg0 = *(const f32x4*)(cw + gc), wg1 = *(const f32x4*)(cw + DUP + gc), wg2 = *(const f32x4*)(cw + 2 * DUP + gc);
                const f32x4 wv0 = *(const f32x4*)(cw + DFF + gc), wv1 = *(const f32x4*)(cw + DUP + DFF + gc), wv2 = *(const f32x4*)(cw + 2 * DUP + DFF + gc);
                f32x4 pgp = {0.f, 0.f, 0.f, 0.f}, pvp = pgp;
#pragma unroll
                for (int m = 0; m < 4; ++m) { const float rs = rsv[m]; const f32x4 pg = acc[ai][0][m][n] * rs, pv = acc[ai][1][m][n] * rs;
                    f32x4 a;
#pragma unroll
                    for (int j = 0; j < 4; ++j) {
                        const float s1g = dpp_f<0x111>(dpp_f<0x121>(0.f, pgp[j]), pg[j]), s2g = dpp_f<0x112>(dpp_f<0x122>(0.f, pgp[j]), pg[j]);
                        const float s1v = dpp_f<0x111>(dpp_f<0x121>(0.f, pvp[j]), pv[j]), s2v = dpp_f<0x112>(dpp_f<0x122>(0.f, pvp[j]), pv[j]);
                        const float G = wg0[j] * s2g + wg1[j] * s1g + wg2[j] * pg[j], V = wv0[j] * s2v + wv1[j] * s1v + wv2[j] * pv[j];
                        a[j] = G * V * sigmoidf_fast(G);
                    }
                    pgp = pg; pvp = pv;
                    const int r = u.pm * BM + ai * HALF + rt0 + m * 16;
                    if (!(m == 0 && fr < 2)) { u32x2 w; w.x = cvt_pk_bf16(a[0], a[1]); w.y = cvt_pk_bf16(a[2], a[3]); *(u32x2*)(act + (size_t)r * DFF + gc) = w; }
                    if (m == 0 && fr < 2) { float* p = sb + ((size_t)blk * 4 + fr) * DUP + gc; *(f32x4*)p = pg; *(f32x4*)(p + DFF) = pv; }
                    if (m == 3 && fr >= 14) { float* p = sb + ((size_t)blk * 4 + fr - 12) * DUP + gc; *(f32x4*)p = pg; *(f32x4*)(p + DFF) = pv; }
                }
            }
        }
    }
};
template <class Epi, class Sched, bool STAMP = false>
__device__ __forceinline__ void gemm_phase(PG8_LAS unsigned char* lds, const Gemm g, const Sched& S, const Epi& E, unsigned long long* stamps) {
    int tid_ = threadIdx.x; asm volatile("" : "+v"(tid_));
    const int tid = tid_, wid = __builtin_amdgcn_readfirstlane(tid >> 6), lane = tid & 63, wr = wid >> 2, wc = wid & 3, fr = lane & 15, fq = lane >> 4;
    const int K = g.K, nt = K / BK;
    int ts_lo = 0, ts_hi = 0, nts = 0; const unsigned long long rt_entry = STAMP ? (unsigned long long)wall_clock64() : 0ull;
#define PG8_STAMP() do { if (STAMP && wid == 0 && nts < 64) { const unsigned long long _c = (unsigned long long)clock64(); \
        ts_lo = (lane == nts) ? (int)(unsigned)_c : ts_lo; ts_hi = (lane == nts) ? (int)(unsigned)(_c >> 32) : ts_hi; ++nts; } } while (0)
    PG8_STAMP();
    unsigned voffA[2], voffB[2];
#pragma unroll
    for (int i = 0; i < 2; ++i) { int R, C; stage_rc(tid * 16 + i * 8192, R, C); const int Rb = Epi::PERM ? ((R & ~31) + perm32(R & 31)) : R;
        voffA[i] = (unsigned)(R * K + C) * 2u; voffB[i] = (unsigned)(Rb * K + C) * 2u; }
    const size_t kstep = (size_t)(BK * 2);
    const size_t hstep = (size_t)HALF * K * 2;
    const size_t tstep = 2 * hstep;
    const unsigned ldsw = (unsigned)wid * 1024u;
    const int aoff = lds_byte(wr * 64 + fr, fq * 8), boff = lds_byte(wc * 32 + fr, fq * 8);
#define PG8_SA(b, h) (((b) * 2 + (h)) * HTB)
#define PG8_SB(b, h) ((4 + (b) * 2 + (h)) * HTB)
#define PG8_STAGE(bufoff, gbase, voff) do { _Pragma("unroll") for (int _i = 0; _i < 2; ++_i) \
        __builtin_amdgcn_global_load_lds((const unsigned*)((const char*)(gbase) + (voff)[_i]), (PG8_LAS unsigned*)(lds + (bufoff) + ldsw + _i * 8192), 16, 0, 0); } while (0)
#define PG8_LDA(dst, b, h) do { _Pragma("unroll") for (int m = 0; m < 4; ++m) _Pragma("unroll") for (int k = 0; k < 2; ++k) dst[m][k] = *(const PG8_LAS bf16x8*)(lds + PG8_SA(b, h) + aoff + m * 2048 + k * 1024); } while (0)
#define PG8_LDB(dst, b, h) do { _Pragma("unroll") for (int n = 0; n < 2; ++n) _Pragma("unroll") for (int k = 0; k < 2; ++k) dst[n][k] = *(const PG8_LAS bf16x8*)(lds + PG8_SB(b, h) + boff + n * 2048 + k * 1024); } while (0)
#define PG8_MMA(ai, bj, At, Bt) do { __builtin_amdgcn_s_setprio(1); _Pragma("unroll") for (int m = 0; m < 4; ++m) _Pragma("unroll") for (int n = 0; n < 2; ++n) _Pragma("unroll") for (int k = 0; k < 2; ++k) \
        acc[ai][bj][m][n] = __builtin_amdgcn_mfma_f32_16x16x32_bf16(Bt[n][k], At[m][k], acc[ai][bj][m][n], 0, 0, 0); __builtin_amdgcn_s_setprio(0); } while (0)
#define PG8_WAIT_V(n) asm volatile("s_waitcnt vmcnt(" #n ")" ::: "memory")
#define PG8_WAIT_L(n) asm volatile("s_waitcnt lgkmcnt(" #n ")" ::: "memory")
#define PG8_BAR __builtin_amdgcn_s_barrier()
#define PG8_SCHED __builtin_amdgcn_sched_barrier(0)
    Unit cur, nxt; int ui = 0;
    if (!S.next(0, cur)) return;
    f32x4 acc[2][2][4][2];
#pragma unroll
    for (int a = 0; a < 2; ++a)
#pragma unroll
        for (int b = 0; b < 2; ++b)
#pragma unroll
            for (int m = 0; m < 4; ++m)
#pragma unroll
                for (int n = 0; n < 2; ++n) acc[a][b][m][n] = (f32x4){0.f, 0.f, 0.f, 0.f};
    bf16x8 At[4][2], B0[2][2], B1[2][2];
    const char* cA = (const char*)g.A + (size_t)cur.pm * tstep; const char* cB = (const char*)g.Bt + (size_t)cur.pn * tstep;
    S.a_ready(cur);
    PG8_STAGE(PG8_SB(0, 0), cB, voffB); PG8_STAGE(PG8_SA(0, 0), cA, voffA); PG8_STAGE(PG8_SB(0, 1), cB + hstep, voffB); PG8_STAGE(PG8_SA(0, 1), cA + hstep, voffA);
    if (wr == 1) PG8_BAR;
    PG8_WAIT_V(4); PG8_BAR;
    PG8_STAGE(PG8_SB(1, 0), cB + kstep, voffB); PG8_STAGE(PG8_SA(1, 0), cA + kstep, voffA); PG8_STAGE(PG8_SB(1, 1), cB + hstep + kstep, voffB);
    PG8_WAIT_V(6); PG8_BAR;
    PG8_STAMP();
    for (;;) {
        const bool has_next = S.next(ui + 1, nxt);
        const char* nA = has_next ? (const char*)g.A + (size_t)nxt.pm * tstep : cA; const char* nB = has_next ? (const char*)g.Bt + (size_t)nxt.pn * tstep : cB;
        for (int t = 0; t < nt; t += 2) {
            const bool last = (t == nt - 2);
            const char* a1 = cA + (size_t)(t + 1) * kstep;
            const char* a2 = last ? nA : cA + (size_t)(t + 2) * kstep; const char* b2 = last ? nB : cB + (size_t)(t + 2) * kstep;
            const char* a3 = a2 + kstep; const char* b3 = b2 + kstep;
            if (last && has_next) S.a_ready(nxt);
            PG8_LDB(B0, 0, 0); PG8_SCHED; PG8_LDA(At, 0, 0); PG8_STAGE(PG8_SA(1, 1), a1 + hstep, voffA);
            PG8_WAIT_L(8); PG8_BAR; PG8_WAIT_L(0); PG8_MMA(0, 0, At, B0); PG8_BAR; PG8_SCHED;
            PG8_LDB(B1, 0, 1); PG8_STAGE(PG8_SB(0, 0), b2, voffB);
            PG8_BAR; PG8_WAIT_L(0); PG8_MMA(0, 1, At, B1); PG8_BAR;
            PG8_LDA(At, 0, 1); PG8_STAGE(PG8_SA(0, 0), a2, voffA);
            PG8_BAR; PG8_WAIT_L(0); PG8_MMA(1, 0, At, B0); PG8_BAR; PG8_SCHED;
            PG8_STAGE(PG8_SB(0, 1), b2 + hstep, voffB);
            PG8_WAIT_V(6); PG8_BAR; PG8_MMA(1, 1, At, B1); PG8_BAR;
            PG8_LDB(B0, 1, 0); PG8_SCHED; PG8_LDA(At, 1, 0); PG8_STAGE(PG8_SA(0, 1), a2 + hstep, voffA);
            PG8_WAIT_L(8); PG8_BAR; PG8_WAIT_L(0); PG8_MMA(0, 0, At, B0); PG8_BAR; PG8_SCHED;
            PG8_LDB(B1, 1, 1); PG8_STAGE(PG8_SB(1, 0), b3, voffB);
            PG8_BAR; PG8_WAIT_L(0); PG8_MMA(0, 1, At, B1); PG8_BAR;
            PG8_LDA(At, 1, 1); PG8_STAGE(PG8_SA(1, 0), a3, voffA);
            PG8_BAR; PG8_WAIT_L(0); PG8_MMA(1, 0, At, B0); PG8_BAR; PG8_SCHED;
            PG8_STAGE(PG8_SB(1, 1), b3 + hstep, voffB);
            PG8_WAIT_V(6); PG8_BAR; PG8_MMA(1, 1, At, B1); PG8_BAR;
        }
        PG8_STAMP();
        if constexpr (!Epi::AFTER_DRAIN) { E(acc, cur, wr, wc, fr, fq); S.done(cur); }
        PG8_STAMP();
        if (!has_next) break;
#pragma unroll
        for (int a = 0; a < 2; ++a)
#pragma unroll
            for (int b = 0; b < 2; ++b)
#pragma unroll
                for (int m = 0; m < 4; ++m)
#pragma unroll
                    for (int n = 0; n < 2; ++n) acc[a][b][m][n] = (f32x4){0.f, 0.f, 0.f, 0.f};
        cur = nxt; cA = nA; cB = nB; ++ui;
    }
    PG8_WAIT_V(0);
    if (wr == 0) PG8_BAR;
    PG8_BAR;
    if constexpr (Epi::AFTER_DRAIN) { E.fused(acc, cur, wr, wc, fr, fq, lds, wid, lane); S.done(cur); }
    PG8_STAMP();
    if (STAMP && wid == 0) { stamps[lane] = lane < nts ? (((unsigned long long)(unsigned)ts_hi << 32) | (unsigned)ts_lo) : 0ull;
        if (lane == 62) stamps[62] = rt_entry; if (lane == 63) stamps[63] = (unsigned long long)wall_clock64(); }
#undef PG8_STAMP
#undef PG8_SA
#undef PG8_SB
#undef PG8_STAGE
#undef PG8_LDA
#undef PG8_LDB
#undef PG8_MMA
#undef PG8_WAIT_V
#undef PG8_WAIT_L
#undef PG8_BAR
#undef PG8_SCHED
}
}

using pg8::bf16_t; using pg8::f32x4; using pg8::u32x4; using pg8::u32x2; using pg8::bf16x8;
using pg8::gelu_tanh; using pg8::DM; using pg8::MROWS; using pg8::NPROMPT; using pg8::DIN; using pg8::DFF; using pg8::DUP; using pg8::DA; using pg8::EPS;
#define LAS __attribute__((address_space(3)))
typedef float f32x16 __attribute__((ext_vector_type(16)));
typedef short s16x4 __attribute__((ext_vector_type(4)));
constexpr int NTHREADS = 512, NWAVES = 8;
constexpr int LDS_BYTES = 131072 + 2048;
constexpr int NBLK64 = MROWS / 64;

constexpr size_t MiB = 1u << 20;
constexpr size_t WS_SS = 0;
constexpr size_t WS_WSB = 1 * MiB;
constexpr size_t WS_WIN = 2 * MiB;
constexpr size_t WS_WOUT = WS_WIN + 2 * 20 * MiB;
constexpr size_t WS_WUP = WS_WOUT + 2 * 8 * MiB;
constexpr size_t WS_WDN = WS_WUP + 2 * 44 * MiB;
constexpr size_t WS_XB = WS_WDN + 2 * 22 * MiB;
constexpr size_t WS_SB = WS_XB + 130 * MiB;
constexpr size_t WS_PROJ = WS_SB + 90 * MiB;
constexpr size_t WS_MIX = WS_PROJ + 325 * MiB;
constexpr size_t WS_ACT = WS_PROJ;
constexpr size_t WS_END = WS_MIX + 130 * MiB;
static_assert((size_t)MROWS * DIN * 2 <= 325 * MiB && (size_t)MROWS * DM * 2 <= 130 * MiB && (size_t)MROWS * DFF * 2 <= 455 * MiB && (size_t)NBLK64 * 4 * DUP * 4 <= 90 * MiB, "ws map");
static_assert(WS_END <= (size_t)1024 * MiB, "ws map fits 1 GiB");
constexpr size_t O_Y = 0, O_PS = (size_t)MROWS * DM, O_PF = O_PS + 2 * 2 * 2 * 1024, O_SV = O_PF + 2 * 2 * 2 * DUP, O_SS = O_SV + 2 * 8 * 64 * 1024, O_SF = O_SS + 2 * 8 * 2 * 1024, O_END = O_SF + 2 * 8 * 2 * DUP;

struct Params { const float* in[18]; float* out; unsigned char* ws; int ph_lo, ph_hi; };
typedef const Params __attribute__((address_space(4)))* CParams;
__device__ __forceinline__ CParams params() { CParams p = (CParams)__builtin_amdgcn_kernarg_segment_ptr(); asm volatile("" : "+s"(p)); return p; }

__device__ __forceinline__ float wave_sum(float v) {
#pragma unroll
    for (int o = 1; o < 64; o <<= 1) v += __shfl_xor(v, o);
    return v;
}
__device__ __forceinline__ unsigned f2bf(float f) { unsigned u = __builtin_bit_cast(unsigned, f); return (u + 0x7fffu + ((u >> 16) & 1u)) >> 16; }
__device__ __forceinline__ unsigned pk2(float lo, float hi) { return f2bf(lo) | (f2bf(hi) << 16); }

__device__ __forceinline__ void transpose_item(const float* W, int K, int N, bf16_t* WT, const float* gk, int interleave, LAS float* scr, int item, int lane) {
    const int nblk = N / 32, kb = item / nblk, nb = item % nblk, k0 = 64 * kb, n0 = 32 * nb;
#pragma unroll 8
    for (int i = 0; i < 32; ++i) { const int kk = 2 * i + (lane >> 5); float w = W[(size_t)(k0 + kk) * N + n0 + (lane & 31)]; if (gk) w *= gk[k0 + kk]; scr[kk * 33 + (lane & 31)] = w; }
    asm volatile("s_waitcnt lgkmcnt(0)" ::: "memory");
    int drow0 = n0;
    if (interleave) drow0 = n0 < DFF ? (n0 / 128) * 256 + (n0 % 128) : ((n0 - DFF) / 128) * 256 + 128 + ((n0 - DFF) % 128);
    const int c = lane & 7;
#pragma unroll
    for (int j = 0; j < 4; ++j) { const int n = (lane >> 3) + 8 * j; const LAS float* s = scr + (8 * c) * 33 + n;
        u32x4 o; o.x = pk2(s[0 * 33], s[1 * 33]); o.y = pk2(s[2 * 33], s[3 * 33]); o.z = pk2(s[4 * 33], s[5 * 33]); o.w = pk2(s[6 * 33], s[7 * 33]);
        *(u32x4*)(WT + (size_t)(drow0 + n) * K + k0 + 8 * c) = o; }
    asm volatile("s_waitcnt lgkmcnt(0)" ::: "memory");
}

__device__ __forceinline__ void prologue_phase(LAS unsigned char* lds, CParams P) {
    const int tid = threadIdx.x, lane = tid & 63, wave = tid >> 6;
    const int gw = blockIdx.x * NWAVES + wave, NGW = gridDim.x * NWAVES;
    unsigned char* ws = P->ws;
    LAS float* scr = (LAS float*)(lds + wave * 16384);
    constexpr int I_IN = (DM / 64) * (DIN / 32), I_OUT = (DM / 64) * (DM / 32), I_UP = (DM / 64) * (DUP / 32), I_DN = (DFF / 64) * (DM / 32), I_L = I_IN + I_OUT + I_UP + I_DN;
    for (int it = gw; it < 2 * I_L; it += NGW) {
        const int l = it / I_L; int r = it % I_L;
        if (r < I_IN) { transpose_item(P->in[5] + (size_t)l * DM * DIN, DM, DIN, (bf16_t*)(ws + WS_WIN + l * 20 * MiB), P->in[4] + l * DM, 0, scr, r, lane); continue; } r -= I_IN;
        if (r < I_OUT) { const int k0 = 64 * (r / (DM / 32)); const float* g = k0 < DA ? P->in[10] + l * DA : P->in[11] + l * DA - DA;
            transpose_item(P->in[12] + (size_t)l * DM * DM, DM, DM, (bf16_t*)(ws + WS_WOUT + l * 8 * MiB), g, 0, scr, r, lane); continue; } r -= I_OUT;
        if (r < I_UP) { transpose_item(P->in[14] + (size_t)l * DM * DUP, DM, DUP, (bf16_t*)(ws + WS_WUP + l * 44 * MiB), P->in[13] + l * DM, 1, scr, r, lane); continue; } r -= I_UP;
        transpose_item(P->in[16] + (size_t)l * DFF * DM, DFF, DM, (bf16_t*)(ws + WS_WDN + l * 22 * MiB), nullptr, 0, scr, r, lane);
    }
    float* ss = (float*)(ws + WS_SS); bf16_t* xb = (bf16_t*)(ws + WS_XB);
    for (int m = gw; m < MROWS; m += NGW) {
        const float* xr = m < NPROMPT ? P->in[0] + (size_t)m * DM : P->in[1] + (size_t)(m - NPROMPT) * DM;
        f32x4 v[8]; float s = 0.f;
#pragma unroll
        for (int j = 0; j < 8; ++j) { v[j] = ((const f32x4*)xr)[lane + 64 * j]; s += (v[j][0] * v[j][0] + v[j][1] * v[j][1]) + (v[j][2] * v[j][2] + v[j][3] * v[j][3]); }
        s = wave_sum(s); if (lane == 0) ss[m] = s;
#pragma unroll
        for (int j = 0; j < 8; ++j) { u32x2 w; w.x = pk2(v[j][0], v[j][1]); w.y = pk2(v[j][2], v[j][3]); ((u32x2*)(xb + (size_t)m * DM))[lane + 64 * j] = w; }
    }
    const int gt = blockIdx.x * NTHREADS + tid, NGT = gridDim.x * NTHREADS;
    for (int i = gt; i < 4 * MROWS; i += NGT) ss[MROWS + i] = 0.f;
    bf16_t* wsb = (bf16_t*)(ws + WS_WSB);
    for (int i = gt; i < 2 * 8 * 128 * 128 / 2; i += NGT) { const float2 w = ((const float2*)P->in[7])[i]; ((unsigned*)wsb)[i] = pk2(w.x, w.y); }
}

__device__ __forceinline__ unsigned off_b(unsigned row, unsigned ch) { return 256u * row + 16u * (ch ^ (((row & 3) << 2) | ((row >> 2) & 3))); }
__device__ __forceinline__ unsigned tr_read_addr(unsigned lane, unsigned c, unsigned ks, unsigned t) {
    const unsigned h = lane >> 5, blk = (lane >> 4) & 1, q = (lane & 15) >> 2, p = lane & 3;
    return off_b(16 * ks + 8 * h + 4 * t + q, 4 * c + 2 * blk + (p >> 1)) + 8 * (p & 1);
}
__device__ __forceinline__ void mixer_phase(LAS unsigned char* lds, CParams P, int l) {
    int tid_ = threadIdx.x; asm volatile("" : "+v"(tid_));
    const int tid = tid_, lane = tid & 63, wave = __builtin_amdgcn_readfirstlane(tid >> 6);
    unsigned char* ws = P->ws;
    const bf16_t* proj = (const bf16_t*)(ws + WS_PROJ); bf16_t* mix = (bf16_t*)(ws + WS_MIX);
    const bf16_t* wsb = (const bf16_t*)(ws + WS_WSB) + (size_t)l * 8 * 128 * 128;
    const float* vg = P->in[6] + l * DA; const float* bs = P->in[8] + l * 8 * 128; const float* scw = P->in[9] + l * 3 * 1024; const float* st_s = P->in[2] + (size_t)l * 8 * 2 * 1024;
    float* oSV = P->out + O_SV + (size_t)l * 8 * 64 * 1024; float* oPS = P->out + O_PS + (size_t)l * 2 * 2 * 1024; float* oSS = P->out + O_SS + (size_t)l * 8 * 2 * 1024;
    LAS float* SSA = (LAS float*)(lds + 32768);
    LAS float* SSB = (LAS float*)(lds + 32768 + 2048);
    LAS float* RA = (LAS float*)(lds + 32768 + 3072);
    LAS float* RB = (LAS float*)(lds + 32768 + 3584);
    const unsigned ldsbase = (unsigned)(size_t)lds;
    const int tb = wave & 3, dh = wave >> 2;
    for (int cu = blockIdx.x; cu < MROWS / 128; cu += gridDim.x) {
        const int row0 = cu * 128; const bool sample = row0 >= NPROMPT;
        float ssA = 0.f;
        const int wt0 = sample ? 32 * (tb & 1) : 32 * tb;
        const int ks_lo = (sample && tb >= 2) ? 4 : 0, ks_hi = (tb >= 2) ? 8 : 4, wcs = (sample && tb >= 2) ? -64 : 0;
        const int t_abs = row0 + 32 * tb + (lane & 31);
        const int tpos = sample ? ((32 * tb + (lane & 31)) & 63) : (32 * tb + (lane & 31));
        for (int h = 0; h < 8; ++h) {
#pragma unroll
            for (int i = 0; i < 4; ++i) { const int n = tid + 512 * i, row = n >> 4, ch = n & 15;
                const u32x4 raw = *(const u32x4*)(proj + (size_t)(row0 + row) * DIN + 1024 + 128 * h + 8 * ch);
                float g[8]; g[0] = gelu_tanh(pg8::bf_lo(raw.x)); g[1] = gelu_tanh(pg8::bf_hi(raw.x)); g[2] = gelu_tanh(pg8::bf_lo(raw.y)); g[3] = gelu_tanh(pg8::bf_hi(raw.y));
                g[4] = gelu_tanh(pg8::bf_lo(raw.z)); g[5] = gelu_tanh(pg8::bf_hi(raw.z)); g[6] = gelu_tanh(pg8::bf_lo(raw.w)); g[7] = gelu_tanh(pg8::bf_hi(raw.w));
                float s = 0.f;
#pragma unroll
                for (int j = 0; j < 8; ++j) s += g[j] * g[j];
                s += __shfl_xor(s, 1); s += __shfl_xor(s, 2); s += __shfl_xor(s, 4); s += __shfl_xor(s, 8);
                const float rn = pg8::rs_of(s, 1.0f / 128.0f);
                const f32x4 g0 = *(const f32x4*)(vg + 128 * h + 8 * ch), g1 = *(const f32x4*)(vg + 128 * h + 8 * ch + 4);
                f32x4 o0, o1;
#pragma unroll
                for (int j = 0; j < 4; ++j) { o0[j] = g[j] * rn * g0[j]; o1[j] = g[4 + j] * rn * g1[j]; }
                if (sample) { float* d = oSV + (size_t)(row0 + row - NPROMPT) * 1024 + 128 * h + 8 * ch; *(f32x4*)d = o0; *(f32x4*)(d + 4) = o1; }
                u32x4 w; w.x = pg8::cvt_pk_bf16(o0[0], o0[1]); w.y = pg8::cvt_pk_bf16(o0[2], o0[3]); w.z = pg8::cvt_pk_bf16(o1[0], o1[1]); w.w = pg8::cvt_pk_bf16(o1[2], o1[3]);
                *(LAS u32x4*)(lds + off_b(row, ch)) = w; }
            __syncthreads();
            f32x16 acc[2];
#pragma unroll
            for (int nb = 0; nb < 2; ++nb)
#pragma unroll
                for (int r = 0; r < 16; ++r) acc[nb][r] = 0.f;
            const bf16_t* wrow = wsb + ((size_t)(h * 128 + wt0 + (lane & 31))) * 128 + wcs + 8 * (lane >> 5);
            const unsigned a00 = ldsbase + tr_read_addr(lane, 2 * dh, 0, 0), a01 = ldsbase + tr_read_addr(lane, 2 * dh, 0, 1);
            const unsigned a10 = ldsbase + tr_read_addr(lane, 2 * dh + 1, 0, 0), a11 = ldsbase + tr_read_addr(lane, 2 * dh + 1, 0, 1);
            for (int ks = ks_lo; ks < ks_hi; ++ks) {
                const bf16x8 wf = *(const bf16x8*)(wrow + 16 * ks);
                s16x4 f00, f01, f10, f11; const unsigned ko = 4096u * ks;
                asm volatile("ds_read_b64_tr_b16 %0, %4\n\tds_read_b64_tr_b16 %1, %5\n\tds_read_b64_tr_b16 %2, %6\n\tds_read_b64_tr_b16 %3, %7\n\ts_waitcnt lgkmcnt(0)"
                             : "=&v"(f00), "=&v"(f01), "=&v"(f10), "=&v"(f11) : "v"(a00 + ko), "v"(a01 + ko), "v"(a10 + ko), "v"(a11 + ko) : "memory");
                const bf16x8 fa = __builtin_shufflevector(f00, f01, 0, 1, 2, 3, 4, 5, 6, 7), fb = __builtin_shufflevector(f10, f11, 0, 1, 2, 3, 4, 5, 6, 7);
                acc[0] = __builtin_amdgcn_mfma_f32_32x32x16_bf16(fa, wf, acc[0], 0, 0, 0);
                acc[1] = __builtin_amdgcn_mfma_f32_32x32x16_bf16(fb, wf, acc[1], 0, 0, 0);
            }
            const float bias = bs[h * 128 + tpos];
#pragma unroll
            for (int nb = 0; nb < 2; ++nb)
#pragma unroll
                for (int rq = 0; rq < 4; ++rq) { const int d0 = 32 * (2 * dh + nb) + 8 * rq + 4 * (lane >> 5);
                    const u32x2 raw = *(const u32x2*)(proj + (size_t)t_abs * DIN + 128 * h + d0);
                    const float a0 = gelu_tanh(pg8::bf_lo(raw.x)) * (acc[nb][4 * rq + 0] + bias), a1 = gelu_tanh(pg8::bf_hi(raw.x)) * (acc[nb][4 * rq + 1] + bias);
                    const float a2 = gelu_tanh(pg8::bf_lo(raw.y)) * (acc[nb][4 * rq + 2] + bias), a3 = gelu_tanh(pg8::bf_hi(raw.y)) * (acc[nb][4 * rq + 3] + bias);
                    ssA += (a0 * a0 + a1 * a1) + (a2 * a2 + a3 * a3);
                    u32x2 w; w.x = pg8::cvt_pk_bf16(a0, a1); w.y = pg8::cvt_pk_bf16(a2, a3); *(u32x2*)(mix + (size_t)t_abs * DM + 128 * h + d0) = w; }
            __syncthreads();
        }
        SSA[(dh * 2 + (lane >> 5)) * 128 + 32 * tb + (lane & 31)] = ssA;
        {
            const int cgp = tid & 127, strip = tid >> 7, c0 = 8 * cgp, r0 = row0 + 32 * strip;
            float w0[8], w1[8], w2[8], q1[8], q2[8];
#pragma unroll
            for (int j = 0; j < 8; ++j) { w0[j] = scw[c0 + j]; w1[j] = scw[1024 + c0 + j]; w2[j] = scw[2048 + c0 + j]; }
            const bool seqstart = sample ? ((strip & 1) == 0) : (strip == 0 && (cu & 127) == 0);
            const int sb_ = sample ? (r0 - NPROMPT) / 64 : 0;
            if (seqstart) {
                if (sample) {
#pragma unroll
                    for (int j = 0; j < 8; ++j) { q2[j] = st_s[(sb_ * 2 + 0) * 1024 + c0 + j]; q1[j] = st_s[(sb_ * 2 + 1) * 1024 + c0 + j]; }
                } else {
#pragma unroll
                    for (int j = 0; j < 8; ++j) { q2[j] = 0.f; q1[j] = 0.f; }
                }
            } else {
                const bf16_t* p2 = proj + (size_t)(r0 - 2) * DIN + 3072 + c0;
                const u32x4 c2 = *(const u32x4*)p2, h2 = *(const u32x4*)(p2 + 1024), c1 = *(const u32x4*)(p2 + DIN), h1 = *(const u32x4*)(p2 + DIN + 1024);
                q2[0] = pg8::bf_lo(c2.x) * pg8::bf_lo(h2.x); q2[1] = pg8::bf_hi(c2.x) * pg8::bf_hi(h2.x); q2[2] = pg8::bf_lo(c2.y) * pg8::bf_lo(h2.y); q2[3] = pg8::bf_hi(c2.y) * pg8::bf_hi(h2.y);
                q2[4] = pg8::bf_lo(c2.z) * pg8::bf_lo(h2.z); q2[5] = pg8::bf_hi(c2.z) * pg8::bf_hi(h2.z); q2[6] = pg8::bf_lo(c2.w) * pg8::bf_lo(h2.w); q2[7] = pg8::bf_hi(c2.w) * pg8::bf_hi(h2.w);
                q1[0] = pg8::bf_lo(c1.x) * pg8::bf_lo(h1.x); q1[1] = pg8::bf_hi(c1.x) * pg8::bf_hi(h1.x); q1[2] = pg8::bf_lo(c1.y) * pg8::bf_lo(h1.y); q1[3] = pg8::bf_hi(c1.y) * pg8::bf_hi(h1.y);
                q1[4] = pg8::bf_lo(c1.z) * pg8::bf_lo(h1.z); q1[5] = pg8::bf_hi(c1.z) * pg8::bf_hi(h1.z); q1[6] = pg8::bf_lo(c1.w) * pg8::bf_lo(h1.w); q1[7] = pg8::bf_hi(c1.w) * pg8::bf_hi(h1.w);
            }
            const bool st_out = sample ? ((strip & 1) == 1) : (strip == 3 && (cu & 127) == 127);
            float* st_dst = sample ? oSS + (size_t)sb_ * 2 * 1024 + c0 : oPS + (size_t)(cu >> 7) * 2 * 1024 + c0;
#pragma unroll 2
            for (int i = 0; i < 32; ++i) {
                const bf16_t* pr = proj + (size_t)(r0 + i) * DIN + 2048 + c0;
                const u32x4 gb = *(const u32x4*)pr, gc = *(const u32x4*)(pr + 1024), hi = *(const u32x4*)(pr + 2048);
                float q[8], b[8], g[8];
                q[0] = pg8::bf_lo(gc.x) * pg8::bf_lo(hi.x); q[1] = pg8::bf_hi(gc.x) * pg8::bf_hi(hi.x); q[2] = pg8::bf_lo(gc.y) * pg8::bf_lo(hi.y); q[3] = pg8::bf_hi(gc.y) * pg8::bf_hi(hi.y);
                q[4] = pg8::bf_lo(gc.z) * pg8::bf_lo(hi.z); q[5] = pg8::bf_hi(gc.z) * pg8::bf_hi(hi.z); q[6] = pg8::bf_lo(gc.w) * pg8::bf_lo(hi.w); q[7] = pg8::bf_hi(gc.w) * pg8::bf_hi(hi.w);
                g[0] = pg8::bf_lo(gb.x); g[1] = pg8::bf_hi(gb.x); g[2] = pg8::bf_lo(gb.y); g[3] = pg8::bf_hi(gb.y); g[4] = pg8::bf_lo(gb.z); g[5] = pg8::bf_hi(gb.z); g[6] = pg8::bf_lo(gb.w); g[7] = pg8::bf_hi(gb.w);
                float s = 0.f;
#pragma unroll
                for (int j = 0; j < 8; ++j) { b[j] = g[j] * (w0[j] * q2[j] + w1[j] * q1[j] + w2[j] * q[j]); s += b[j] * b[j]; }
                u32x4 w; w.x = pg8::cvt_pk_bf16(b[0], b[1]); w.y = pg8::cvt_pk_bf16(b[2], b[3]); w.z = pg8::cvt_pk_bf16(b[4], b[5]); w.w = pg8::cvt_pk_bf16(b[6], b[7]);
                *(u32x4*)(mix + (size_t)(r0 + i) * DM + 1024 + c0) = w;
                if (st_out && i >= 30) { float* d = st_dst + (i - 30) * 1024; *(f32x4*)d = (f32x4){q[0], q[1], q[2], q[3]}; *(f32x4*)(d + 4) = (f32x4){q[4], q[5], q[6], q[7]}; }
                s = wave_sum(s);
                if (lane == 0) SSB[((tid >> 6) & 1) * 128 + 32 * strip + i] = s;
#pragma unroll
                for (int j = 0; j < 8; ++j) { q2[j] = q1[j]; q1[j] = q[j]; }
            }
        }
        __syncthreads();
        if (tid < 128) { RA[tid] = pg8::rs_of(SSA[tid] + SSA[128 + tid] + SSA[256 + tid] + SSA[384 + tid], 1.0f / 1024.0f); RB[tid] = pg8::rs_of(SSB[tid] + SSB[128 + tid], 1.0f / 1024.0f); }
        __syncthreads();
#pragma unroll 4
        for (int i = 0; i < 64; ++i) { const int n = tid + 512 * i, row = n >> 8, pc = n & 255; const float sc = pc < 128 ? RA[row] : RB[row];
            u32x4* p = (u32x4*)(mix + (size_t)(row0 + row) * DM + 8 * pc); const u32x4 raw = *p; u32x4 w;
            w.x = pg8::cvt_pk_bf16(pg8::bf_lo(raw.x) * sc, pg8::bf_hi(raw.x) * sc); w.y = pg8::cvt_pk_bf16(pg8::bf_lo(raw.y) * sc, pg8::bf_hi(raw.y) * sc);
            w.z = pg8::cvt_pk_bf16(pg8::bf_lo(raw.z) * sc, pg8::bf_hi(raw.z) * sc); w.w = pg8::cvt_pk_bf16(pg8::bf_lo(raw.w) * sc, pg8::bf_hi(raw.w) * sc); *p = w; }
        __syncthreads();
    }
}

__device__ __forceinline__ void fixup_phase(CParams P, int l) {
    unsigned char* ws = P->ws; const float* sb = (const float*)(ws + WS_SB); bf16_t* act = (bf16_t*)(ws + WS_ACT);
    const float* cw = P->in[15] + (size_t)l * 3 * DUP; const float* st_f = P->in[3] + (size_t)l * 8 * 2 * DUP;
    const int gt = blockIdx.x * NTHREADS + threadIdx.x, NGT = gridDim.x * NTHREADS;
    constexpr int NQ = DFF / 4;
    for (int it = gt; it < NBLK64 * 2 * NQ; it += NGT) {
        const int cq = it % NQ, bj = it / NQ, j = bj & 1, blk = bj >> 1, c = 4 * cq;
        const f32x4 z = {0.f, 0.f, 0.f, 0.f};
        f32x4 xg[4], xv[4];
        const float* s0 = sb + (size_t)blk * 4 * DUP + c;
        xg[2] = *(const f32x4*)s0; xv[2] = *(const f32x4*)(s0 + DFF); xg[3] = *(const f32x4*)(s0 + DUP); xv[3] = *(const f32x4*)(s0 + DUP + DFF);
        if (blk >= 512) { const float* sp = st_f + (size_t)(blk - 512) * 2 * DUP + c; xg[0] = *(const f32x4*)sp; xv[0] = *(const f32x4*)(sp + DFF); xg[1] = *(const f32x4*)(sp + DUP); xv[1] = *(const f32x4*)(sp + DUP + DFF); }
        else if ((blk & 255) == 0) { xg[0] = z; xv[0] = z; xg[1] = z; xv[1] = z; }
        else { const float* sp = s0 - 2 * DUP; xg[0] = *(const f32x4*)sp; xv[0] = *(const f32x4*)(sp + DFF); xg[1] = *(const f32x4*)(sp + DUP); xv[1] = *(const f32x4*)(sp + DUP + DFF); }
        const f32x4 wg0 = *(const f32x4*)(cw + c), wg1 = *(const f32x4*)(cw + DUP + c), wg2 = *(const f32x4*)(cw + 2 * DUP + c);
        const f32x4 wv0 = *(const f32x4*)(cw + DFF + c), wv1 = *(const f32x4*)(cw + DUP + DFF + c), wv2 = *(const f32x4*)(cw + 2 * DUP + DFF + c);
        const f32x4 tg0 = j ? xg[1] : xg[0], tg1 = j ? xg[2] : xg[1], tg2 = j ? xg[3] : xg[2], tv0 = j ? xv[1] : xv[0], tv1 = j ? xv[2] : xv[1], tv2 = j ? xv[3] : xv[2];
        const f32x4 G = wg0 * tg0 + wg1 * tg1 + wg2 * tg2, V = wv0 * tv0 + wv1 * tv1 + wv2 * tv2;
        f32x4 a;
#pragma unroll
        for (int e = 0; e < 4; ++e) a[e] = G[e] * V[e] * pg8::sigmoidf_fast(G[e]);
        u32x2 w; w.x = pg8::cvt_pk_bf16(a[0], a[1]); w.y = pg8::cvt_pk_bf16(a[2], a[3]);
        *(u32x2*)(act + (size_t)(blk * 64 + j) * DFF + c) = w;
    }
    float* oPF = P->out + O_PF + (size_t)l * 2 * 2 * DUP; float* oSF = P->out + O_SF + (size_t)l * 8 * 2 * DUP;
    constexpr int NQ2 = DUP / 4;
    for (int it = gt; it < 10 * 2 * NQ2; it += NGT) { const int cq = it % NQ2, sj = it / NQ2, j = sj & 1, s = sj >> 1;
        const int blk = s < 2 ? 256 * s + 255 : 512 + (s - 2);
        const f32x4 v = *(const f32x4*)(sb + ((size_t)blk * 4 + 2 + j) * DUP + 4 * cq);
        float* d = s < 2 ? oPF + ((size_t)s * 2 + j) * DUP : oSF + ((size_t)(s - 2) * 2 + j) * DUP;
        *(f32x4*)(d + 4 * cq) = v; }
}

__device__ __forceinline__ void final_phase(CParams P) {
    const int tid = threadIdx.x, lane = tid & 63, wave = tid >> 6;
    const int gw = blockIdx.x * NWAVES + wave, NGW = gridDim.x * NWAVES;
    const float* ss = (const float*)(P->ws + WS_SS) + 4 * MROWS; const float* g = P->in[17];
    f32x4 gv[8];
#pragma unroll
    for (int j = 0; j < 8; ++j) gv[j] = ((const f32x4*)g)[lane + 64 * j];
    for (int m = gw; m < MROWS; m += NGW) { const float rs = pg8::rs_of(ss[m], 1.0f / DM); f32x4* xr = (f32x4*)(P->out + (size_t)m * DM);
#pragma unroll
        for (int j = 0; j < 8; ++j) { const f32x4 v = xr[lane + 64 * j]; xr[lane + 64 * j] = v * rs * gv[j]; } }
}

constexpr int N_PHASES = 14;
__global__ void __launch_bounds__(NTHREADS, 2) mk_fwd(Params Parg) {
    extern __shared__ __attribute__((aligned(16))) unsigned char lds_raw[];
    LAS unsigned char* lds = (LAS unsigned char*)lds_raw;
    cg::grid_group grid = cg::this_grid();
    int lo, hi; { CParams P = params(); lo = P->ph_lo; hi = P->ph_hi; }
#ifdef ONLY
#define IN(k) ((k) == ONLY)
#else
#define IN(k) (lo <= (k) && (k) < hi)
#endif
#define SEAM(k) do { if (IN(k) && IN((k) + 1)) grid.sync(); } while (0)
    if (IN(0)) { prologue_phase(lds, params()); __syncthreads(); }
    SEAM(0);
#pragma nounroll
    for (int l = 0; l < 2; ++l) {
        const int pb = 1 + 6 * l;
        if (IN(pb)) {
            CParams P = params(); unsigned char* ws = P->ws; float* ss = (float*)(ws + WS_SS);
            pg8::Gemm g{(const bf16_t*)(ws + WS_XB), (const bf16_t*)(ws + WS_WIN + l * 20 * MiB), MROWS, DIN, DM}; pg8::StaticOrder S; S.init(MROWS, DIN, gridDim.x, blockIdx.x);
            pg8::EpiProj E{(bf16_t*)(ws + WS_PROJ), ss + (l == 0 ? 0 : 2 * MROWS)};
            pg8::gemm_phase<pg8::EpiProj, pg8::StaticOrder>(lds, g, S, E, nullptr);
        }
        SEAM(pb);
        if (IN(pb + 1)) mixer_phase(lds, params(), l);
        SEAM(pb + 1);
        if (IN(pb + 2)) {
            CParams P = params(); unsigned char* ws = P->ws; float* ss = (float*)(ws + WS_SS); float* out = P->out;
            pg8::Gemm g{(const bf16_t*)(ws + WS_MIX), (const bf16_t*)(ws + WS_WOUT + l * 8 * MiB), MROWS, DM, DM}; pg8::StaticOrder S; S.init(MROWS, DM, gridDim.x, blockIdx.x);
            pg8::EpiResid E{l == 0 ? P->in[0] : out, l == 0 ? P->in[1] : out + (size_t)NPROMPT * DM, out, (bf16_t*)(ws + WS_XB), ss + (1 + 2 * l) * MROWS};
            pg8::gemm_phase<pg8::EpiResid, pg8::StaticOrder>(lds, g, S, E, nullptr);
        }
        SEAM(pb + 2);
        if (IN(pb + 3)) {
            CParams P = params(); unsigned char* ws = P->ws; float* ss = (float*)(ws + WS_SS);
            pg8::Gemm g{(const bf16_t*)(ws + WS_XB), (const bf16_t*)(ws + WS_WUP + l * 44 * MiB), MROWS, DUP, DM}; pg8::StaticOrder S; S.init(MROWS, DUP, gridDim.x, blockIdx.x);
            pg8::EpiFfn E{(bf16_t*)(ws + WS_ACT), ss + (1 + 2 * l) * MROWS, P->in[15] + (size_t)l * 3 * DUP, (float*)(ws + WS_SB)};
            pg8::gemm_phase<pg8::EpiFfn, pg8::StaticOrder>(lds, g, S, E, nullptr);
        }
        SEAM(pb + 3);
        if (IN(pb + 4)) fixup_phase(params(), l);
        SEAM(pb + 4);
        if (IN(pb + 5)) {
            CParams P = params(); unsigned char* ws = P->ws; float* ss = (float*)(ws + WS_SS); float* out = P->out;
            pg8::Gemm g{(const bf16_t*)(ws + WS_ACT), (const bf16_t*)(ws + WS_WDN + l * 22 * MiB), MROWS, DM, DFF}; pg8::StaticOrder S; S.init(MROWS, DM, gridDim.x, blockIdx.x);
            pg8::EpiResid E{out, out + (size_t)NPROMPT * DM, out, l == 0 ? (bf16_t*)(ws + WS_XB) : nullptr, ss + (2 + 2 * l) * MROWS};
            pg8::gemm_phase<pg8::EpiResid, pg8::StaticOrder>(lds, g, S, E, nullptr);
        }
        SEAM(pb + 5);
    }
    if (IN(13)) final_phase(params());
#undef IN
#undef SEAM
}

#ifndef MK_MULTI
#define MK_MULTI 0
#endif
extern "C" void kernel_launch(void* const* d_in, const int* in_sizes, int n_in, void* d_out, int out_size, void* d_ws, size_t ws_size, hipStream_t stream) {
    static int grid = 0;
    if (grid == 0) {
        if (n_in != 18 || (size_t)out_size != O_END || ws_size < WS_END) { fprintf(stderr, "kernel_launch: unexpected shapes: n_in %d out %d ws %zu (need %zu)\n", n_in, out_size, ws_size, (size_t)WS_END); grid = -1; return; }
        int dev = 0, cus = 0, per_cu = 0;
        hipGetDevice(&dev); hipDeviceGetAttribute(&cus, hipDeviceAttributeMultiprocessorCount, dev);
        if (hipFuncSetAttribute((const void*)mk_fwd, hipFuncAttributeMaxDynamicSharedMemorySize, LDS_BYTES) != hipSuccess) { fprintf(stderr, "kernel_launch: hipFuncSetAttribute failed\n"); grid = -1; return; }
        if (hipOccupancyMaxActiveBlocksPerMultiprocessor(&per_cu, (const void*)mk_fwd, NTHREADS, LDS_BYTES) != hipSuccess || per_cu < 1) { fprintf(stderr, "kernel_launch: occupancy query says %d\n", per_cu); per_cu = 1; }
        (void)hipGetLastError();
        grid = cus * 1;
        fprintf(stderr, "kernel_launch: grid %d (cus %d, per_cu %d)\n", grid, cus, per_cu);
    }
    if (grid < 0) return;
    Params p{};
    for (int i = 0; i < 18; ++i) p.in[i] = (const float*)d_in[i];
    p.out = (float*)d_out; p.ws = (unsigned char*)d_ws;
#if MK_MULTI
    for (int k = 0; k < N_PHASES; ++k) { p.ph_lo = k; p.ph_hi = k + 1; hipLaunchKernelGGL(mk_fwd, dim3(grid), dim3(NTHREADS), LDS_BYTES, stream, p); }
#else
    p.ph_lo = 0; p.ph_hi = N_PHASES;
    void* args[] = {&p};
    hipError_t e = hipLaunchCooperativeKernel((const void*)mk_fwd, dim3(grid), dim3(NTHREADS), args, LDS_BYTES, stream);
    if (e != hipSuccess) fprintf(stderr, "kernel_launch: cooperative launch failed: %s (grid %d)\n", hipGetErrorString(e), grid);
#endif
}
```

```cpp
#include <hip/hip_runtime.h>
#include <hip/hip_cooperative_groups.h>
#include <cstdio>
namespace cg = cooperative_groups;
namespace pg8 {
#define PG8_LAS __attribute__((address_space(3)))
typedef unsigned short bf16_t;
typedef short bf16x8 __attribute__((ext_vector_type(8)));
typedef float f32x4 __attribute__((ext_vector_type(4)));
typedef unsigned u32x4 __attribute__((ext_vector_type(4)));
constexpr int BM = 256, BK = 64, HALF = 128, HTB = HALF * BK * 2  , STAGE_BYTES = 8 * HTB, NXCD = 8, WGM = 8;

__host__ __device__ __forceinline__ int lds_byte(int r, int c) { const int st = (r >> 4) * 2 + (c >> 5), rr = r & 15, cc = c & 31, ob = rr * 64 + cc * 2; return st * 1024 + (ob ^ (((ob >> 9) & 1) << 5)); }
__host__ __device__ __forceinline__ void stage_rc(int b, int& R, int& C) { const int st = b / 1024, sb = b % 1024, swz = sb ^ (((sb >> 9) & 1) << 5); R = (st >> 1) * 16 + swz / 64; C = (st & 1) * 32 + (swz % 64) / 2; }
__host__ __device__ __forceinline__ int perm32(int rho) { const int n = rho >> 4, i = rho & 15; return 8 * (i >> 2) + 4 * n + (i & 3); }

struct Unit { int pm, pn, kt0, nkt; };
struct Gemm { const bf16_t* A; const bf16_t* Bt; int M, N, K; };

struct StaticOrder {
    int nM, nN, nwg, G, c;
    __host__ __device__ void init(int M, int N, int G_, int c_) { nM = M / BM; nN = N / BM; nwg = nM * nN; G = G_; c = c_; }
    __host__ __device__ bool next(int i, Unit& u) const {
        const long L = (long)i * G + c; if (L >= nwg) return false;
        int wgid = (int)L; { const int q = nwg / NXCD, r = nwg % NXCD, xcd = wgid % NXCD, off = wgid / NXCD; wgid = (xcd < r ? xcd * (q + 1) : r * (q + 1) + (xcd - r) * q) + off; }
        const int nig = WGM * nN, gid = wgid / nig, fm = gid * WGM, gsz = (nM - fm) < WGM ? (nM - fm) : WGM;
        u.pm = fm + ((wgid % nig) % gsz); u.pn = (wgid % nig) / gsz; u.kt0 = 0; u.nkt = 0; return true;
    }
    __device__ __forceinline__ void a_ready(const Unit&) const {}
    __device__ __forceinline__ void done(const Unit&) const {}
};
__device__ __forceinline__ unsigned cvt_pk_bf16(float lo, float hi) { unsigned r; asm volatile("v_cvt_pk_bf16_f32 %0, %1, %2" : "=v"(r) : "v"(lo), "v"(hi)); return r; }
typedef float f32x2 __attribute__((ext_vector_type(2)));

constexpr int DM = 2048, MROWS = 33280, NPROMPT = 32768, DIN = 5120, DFF = 5632, DUP = 11264, DA = 1024;
constexpr float EPS = 1e-6f;
typedef unsigned u32x2 __attribute__((ext_vector_type(2)));
__device__ __forceinline__ float rs_of(float ss, float invn) { return __builtin_amdgcn_rsqf(ss * invn + EPS); }
__device__ __forceinline__ float bf_lo(unsigned w) { return __uint_as_float(w << 16); }
__device__ __forceinline__ float bf_hi(unsigned w) { return __uint_as_float(w & 0xffff0000u); }
__device__ __forceinline__ float sigmoidf_fast(float x) { return __builtin_amdgcn_rcpf(1.0f + __builtin_amdgcn_exp2f(-1.44269504089f * x)); }
__device__ __forceinline__ float gelu_tanh(float x) { const float u = 1.5957691216f * x * (1.0f + 0.044715f * x * x); return x * sigmoidf_fast(u); }
template <int CTRL> __device__ __forceinline__ float dpp_mov(float src) {
    return __builtin_bit_cast(float, __builtin_amdgcn_mov_dpp(__builtin_bit_cast(int, src), CTRL, 0xf, 0xf, true)); }
template <int CTRL> __device__ __forceinline__ float dpp_f(float old, float src) {
    return __builtin_bit_cast(float, __builtin_amdgcn_update_dpp(__builtin_bit_cast(int, old), __builtin_bit_cast(int, src), CTRL, 0xf, 0xf, false)); }

struct SplitOrder {
    StaticOrder base; int nN, nsplit, nkt_item, nitems, G, c;
    __host__ __device__ void init(int N, int G_, int c_, int nsplit_, int nkt_item_) { base.init(NPROMPT, N, G_, c_); nN = N / BM; nsplit = nsplit_; nkt_item = nkt_item_; nitems = ((MROWS - NPROMPT) / BM) * nN * nsplit; G = G_; c = c_; }
    __host__ __device__ bool next(int i, Unit& u) const {
        const int np = c < base.nwg ? (base.nwg - c + G - 1) / G : 0;
        if (i < np) return base.next(i, u);
        const int j = (i - np) * G + c; if (j >= nitems) return false;
        const int tile = j / nsplit; u.pm = NPROMPT / BM + tile / nN; u.pn = tile % nN; u.kt0 = (j % nsplit) * nkt_item; u.nkt = nkt_item; return true;
    }
    __device__ __forceinline__ void a_ready(const Unit&) const {}
    __device__ __forceinline__ void done(const Unit&) const {}
};
__device__ __forceinline__ size_t proj_off(int r, int c) { return ((size_t)(r >> 7) * 32 + (c >> 7)) * 16384 + (size_t)(r & 127) * 128 + (c & 127); }
struct EpiProj {
    static constexpr bool PERM = true, AFTER_DRAIN = false, MIDK = false;
    bf16_t* O; const float* ss;
    __device__ __forceinline__ void operator()(f32x4 (&acc)[2][2][4][2], const Unit& u, int wr, int wc, int fr, int fq) const {
        const int row0 = u.pm * BM + wr * 64 + fr, col0 = u.pn * BM + wc * 32 + 8 * fq;
        float rsv[2][4];
#pragma unroll
        for (int ai = 0; ai < 2; ++ai)
#pragma unroll
            for (int m = 0; m < 4; ++m) rsv[ai][m] = ss[row0 + ai * HALF + m * 16];
#pragma unroll
        for (int ai = 0; ai < 2; ++ai)
#pragma unroll
            for (int m = 0; m < 4; ++m) { const int r = row0 + ai * HALF + m * 16; const float rs = rs_of(rsv[ai][m], 1.0f / DM);
                if (u.pn >= 12) {
                    const float rq = rs * rs; const f32x4 v0 = acc[ai][0][m][0] * acc[ai][1][m][0] * rq, v1 = acc[ai][0][m][1] * acc[ai][1][m][1] * rq;
                    u32x4 w; w.x = cvt_pk_bf16(v0[0], v0[1]); w.y = cvt_pk_bf16(v0[2], v0[3]); w.z = cvt_pk_bf16(v1[0], v1[1]); w.w = cvt_pk_bf16(v1[2], v1[3]);
                    *(u32x4*)(O + proj_off(r, 3072 + (u.pn - 12) * HALF + wc * 32 + 8 * fq)) = w;
                } else {
                bf16_t* rowp = O + proj_off(r, col0);
#pragma unroll
                for (int bj = 0; bj < 2; ++bj) { const f32x4 v0 = acc[ai][bj][m][0] * rs, v1 = acc[ai][bj][m][1] * rs;
                    u32x4 w; w.x = cvt_pk_bf16(v0[0], v0[1]); w.y = cvt_pk_bf16(v0[2], v0[3]); w.z = cvt_pk_bf16(v1[0], v1[1]); w.w = cvt_pk_bf16(v1[2], v1[3]);
                    *(u32x4*)(rowp + bj * 16384) = w; } } }
    }
};
template <bool SCALE> struct EpiResid {
    static constexpr bool PERM = true, AFTER_DRAIN = false, MIDK = SCALE;
    const float* baseP; const float* baseS; float* out; bf16_t* xb; float* ssout; float* part; const float* rab; int wxb;
    __device__ __forceinline__ void midk(f32x4 (&acc)[2][2][4][2], const Unit& u, int wr, int fr) const {
        float q[2][4];
#pragma unroll
        for (int ai = 0; ai < 2; ++ai)
#pragma unroll
            for (int m = 0; m < 4; ++m) q[ai][m] = rab[2 * (u.pm * BM + wr * 64 + fr + ai * HALF + m * 16)];
#pragma unroll
        for (int ai = 0; ai < 2; ++ai)
#pragma unroll
            for (int m = 0; m < 4; ++m)
#pragma unroll
                for (int bj = 0; bj < 2; ++bj)
#pragma unroll
                    for (int n = 0; n < 2; ++n) acc[ai][bj][m][n] *= q[ai][m];
    }
    __device__ __forceinline__ void operator()(f32x4 (&acc)[2][2][4][2], const Unit& u, int wr, int wc, int fr, int fq) const {
        const int row0 = u.pm * BM + wr * 64 + fr, col0 = u.pn * BM + wc * 32 + 8 * fq;
        if (u.nkt) {
            bf16_t* pp = (bf16_t*)part + ((size_t)(u.kt0 / u.nkt) * (MROWS - NPROMPT) + (row0 - NPROMPT)) * DM + col0;
            float f[2][4];
#pragma unroll
            for (int ai = 0; ai < 2; ++ai)
#pragma unroll
                for (int m = 0; m < 4; ++m) { f[ai][m] = 1.0f;
                    if (SCALE) { const float* rp = rab + 2 * (row0 + ai * HALF + m * 16); const float rb = rp[1]; f[ai][m] = u.kt0 < 16 ? rp[0] * rb : rb; } }
#pragma unroll
            for (int ai = 0; ai < 2; ++ai)
#pragma unroll
                for (int m = 0; m < 4; ++m)
#pragma unroll
                    for (int bj = 0; bj < 2; ++bj) { const f32x4 o0 = acc[ai][bj][m][0] * f[ai][m], o1 = acc[ai][bj][m][1] * f[ai][m];
                        u32x4 w; w.x = cvt_pk_bf16(o0[0], o0[1]); w.y = cvt_pk_bf16(o0[2], o0[3]); w.z = cvt_pk_bf16(o1[0], o1[1]); w.w = cvt_pk_bf16(o1[2], o1[3]);
                        *(u32x4*)(pp + (size_t)(ai * HALF + m * 16) * DM + bj * HALF) = w; }
            return;
        }
        const bf16_t* bb = xb + (size_t)row0 * DM + col0;
        u32x4 hb[2][4][2]; float rbv[2][4];
#pragma unroll
        for (int ai = 0; ai < 2; ++ai)
#pragma unroll
            for (int m = 0; m < 4; ++m) {
#pragma unroll
                for (int bj = 0; bj < 2; ++bj) hb[ai][m][bj] = *(const u32x4*)(bb + (size_t)(ai * HALF + m * 16) * DM + bj * HALF);
                rbv[ai][m] = SCALE ? rab[2 * (row0 + ai * HALF + m * 16) + 1] : 1.0f; }
        asm volatile("" ::: "memory");
#pragma unroll
        for (int ai = 0; ai < 2; ++ai)
#pragma unroll
            for (int m = 0; m < 4; ++m) { const int r = row0 + ai * HALF + m * 16; float s = 0.f;
#pragma unroll
                for (int bj = 0; bj < 2; ++bj) { const u32x4 h = hb[ai][m][bj];
                    const f32x4 b0 = {bf_lo(h.x), bf_hi(h.x), bf_lo(h.y), bf_hi(h.y)}, b1 = {bf_lo(h.z), bf_hi(h.z), bf_lo(h.w), bf_hi(h.w)};
                    const f32x4 o0 = SCALE ? acc[ai][bj][m][0] * rbv[ai][m] + b0 : acc[ai][bj][m][0] + b0, o1 = SCALE ? acc[ai][bj][m][1] * rbv[ai][m] + b1 : acc[ai][bj][m][1] + b1;
                    s += ((o0[0] * o0[0] + o0[1] * o0[1]) + (o0[2] * o0[2] + o0[3] * o0[3])) + ((o1[0] * o1[0] + o1[1] * o1[1]) + (o1[2] * o1[2] + o1[3] * o1[3]));
                    u32x4 w; w.x = cvt_pk_bf16(o0[0], o0[1]); w.y = cvt_pk_bf16(o0[2], o0[3]); w.z = cvt_pk_bf16(o1[0], o1[1]); w.w = cvt_pk_bf16(o1[2], o1[3]);
                    *(u32x4*)(xb + (size_t)r * DM + col0 + bj * HALF) = w; }
                s += __shfl_xor(s, 16); s += __shfl_xor(s, 32);
                if (ssout && fq == 0) unsafeAtomicAdd(ssout + r, s); }
    }
};
struct EpiFfn {
    static constexpr bool PERM = true, AFTER_DRAIN = false, MIDK = false;
    bf16_t* act; const float* ss; const float* cw; float* sb; PG8_LAS float* wl;
    __device__ __forceinline__ void operator()(f32x4 (&acc)[2][2][4][2], const Unit& u, int wr, int wc, int fr, int fq) const {
        const int rt0 = wr * 64 + fr, gc0 = u.pn * 128 + wc * 32 + 8 * fq;
        PG8_LAS float* wimg = wl + (wr * 4 + wc) * 192;
        if (fr < 6) { const float* src = cw + (size_t)(fr % 3) * DUP + (fr / 3) * DFF + gc0; const f32x4 w0 = *(const f32x4*)src, w1 = *(const f32x4*)(src + 4);
            *(PG8_LAS f32x4*)(wimg + fr * 32 + 8 * fq) = w0; *(PG8_LAS f32x4*)(wimg + fr * 32 + 8 * fq + 4) = w1; }
        {
            float rsv[2][4];
#pragma unroll
            for (int ai = 0; ai < 2; ++ai)
#pragma unroll
                for (int m = 0; m < 4; ++m) rsv[ai][m] = ss[u.pm * BM + rt0 + ai * HALF + m * 16];
#pragma unroll
            for (int ai = 0; ai < 2; ++ai)
#pragma unroll
                for (int m = 0; m < 4; ++m) { const float rs = rs_of(rsv[ai][m], 1.0f / DM);
#pragma unroll
                    for (int bj = 0; bj < 2; ++bj)
#pragma unroll
                        for (int n = 0; n < 2; ++n) acc[ai][bj][m][n] *= rs; }
        }
#pragma unroll
        for (int ai = 0; ai < 2; ++ai) { const int blk = u.pm * 4 + ai * 2 + wr;
            u32x2 keep[4];
#pragma unroll
            for (int n = 0; n < 2; ++n) { const int gc = gc0 + 4 * n;
                const PG8_LAS float* wq = wimg + 8 * fq + 4 * n;
                const f32x4 wg0 = *(const PG8_LAS f32x4*)wq, wg1 = *(const PG8_LAS f32x4*)(wq + 32), wg2 = *(const PG8_LAS f32x4*)(wq + 64);
                const f32x4 wv0 = *(const PG8_LAS f32x4*)(wq + 96), wv1 = *(const PG8_LAS f32x4*)(wq + 128), wv2 = *(const PG8_LAS f32x4*)(wq + 160);
#pragma unroll
                for (int m = 0; m < 4; ++m) { const f32x4 pg = acc[ai][0][m][n], pv = acc[ai][1][m][n];
                    const f32x4 pgp = acc[ai][0][m ? m - 1 : 0][n], pvp = acc[ai][1][m ? m - 1 : 0][n];
                    f32x4 a;
#pragma unroll
                    for (int h = 0; h < 2; ++h) {
                        f32x2 s1g, s2g, s1v, s2v;
#pragma unroll
                        for (int k = 0; k < 2; ++k) { const int j = 2 * h + k;
                            if (m) { s1g[k] = dpp_f<0x111>(dpp_mov<0x121>(pgp[j]), pg[j]); s2g[k] = dpp_f<0x112>(dpp_mov<0x122>(pgp[j]), pg[j]);
                                     s1v[k] = dpp_f<0x111>(dpp_mov<0x121>(pvp[j]), pv[j]); s2v[k] = dpp_f<0x112>(dpp_mov<0x122>(pvp[j]), pv[j]); }
                            else   { s1g[k] = dpp_mov<0x111>(pg[j]); s2g[k] = dpp_mov<0x112>(pg[j]); s1v[k] = dpp_mov<0x111>(pv[j]); s2v[k] = dpp_mov<0x112>(pv[j]); } }
                        const f32x2 pg2 = {pg[2 * h], pg[2 * h + 1]}, pv2 = {pv[2 * h], pv[2 * h + 1]};
                        const f32x2 G = (f32x2){wg0[2 * h], wg0[2 * h + 1]} * s2g + (f32x2){wg1[2 * h], wg1[2 * h + 1]} * s1g + (f32x2){wg2[2 * h], wg2[2 * h + 1]} * pg2;
                        const f32x2 V = (f32x2){wv0[2 * h], wv0[2 * h + 1]} * s2v + (f32x2){wv1[2 * h], wv1[2 * h + 1]} * s1v + (f32x2){wv2[2 * h], wv2[2 * h + 1]} * pv2;
                        const f32x2 GV = G * V;
                        a[2 * h] = GV[0] * sigmoidf_fast(G[0]); a[2 * h + 1] = GV[1] * sigmoidf_fast(G[1]);
                    }
                    const int r = u.pm * BM + ai * HALF + rt0 + m * 16;
                    { u32x2 w; w.x = cvt_pk_bf16(a[0], a[1]); w.y = cvt_pk_bf16(a[2], a[3]);
                      if (n == 0) keep[m] = w;
                      else if (!(m == 0 && fr < 2)) { u32x4 w4; w4.x = keep[m].x; w4.y = keep[m].y; w4.z = w.x; w4.w = w.y; *(u32x4*)(act + (size_t)r * DFF + gc0) = w4; } }
                    if (m == 0 && fr < 2) { float* p = sb + ((size_t)blk * 4 + fr) * DUP + gc; *(f32x4*)p = pg; *(f32x4*)(p + DFF) = pv; }
                    if (m == 3 && fr >= 14) { float* p = sb + ((size_t)blk * 4 + fr - 12) * DUP + gc; *(f32x4*)p = pg; *(f32x4*)(p + DFF) = pv; }
                }
            }
        }
    }
};
template <class Epi, class Sched, bool STAMP = false>
__device__ __forceinline__ void gemm_phase(PG8_LAS unsigned char* lds, const Gemm g, const Sched& S, const Epi& E, unsigned long long* stamps) {
    int tid_ = threadIdx.x; asm volatile("" : "+v"(tid_));
    const int tid = tid_, wid = __builtin_amdgcn_readfirstlane(tid >> 6), lane = tid & 63, wr = wid >> 2, wc = wid & 3, fr = lane & 15, fq = lane >> 4;
    const int K = g.K, nt = K / BK;
    int ts_lo = 0, ts_hi = 0, nts = 0; const unsigned long long rt_entry = STAMP ? (unsigned long long)wall_clock64() : 0ull;
#define PG8_STAMP() do { if (STAMP && wid == 0 && nts < 64) { const unsigned long long _c = (unsigned long long)clock64(); \
        ts_lo = (lane == nts) ? (int)(unsigned)_c : ts_lo; ts_hi = (lane == nts) ? (int)(unsigned)(_c >> 32) : ts_hi; ++nts; } } while (0)
    PG8_STAMP();
    unsigned voffA[2], voffB[2];
#pragma unroll
    for (int i = 0; i < 2; ++i) { int R, C; stage_rc(tid * 16 + i * 8192, R, C); const int Rb = Epi::PERM ? ((R & ~31) + perm32(R & 31)) : R;
        voffA[i] = (unsigned)(R * K + C) * 2u; voffB[i] = (unsigned)(Rb * K + C) * 2u; }
    const size_t kstep = (size_t)(BK * 2);
    const size_t hstep = (size_t)HALF * K * 2;
    const size_t tstep = 2 * hstep;
    const unsigned ldsw = (unsigned)wid * 1024u;
    const int aoff = lds_byte(wr * 64 + fr, fq * 8), boff = lds_byte(wc * 32 + fr, fq * 8);
#define PG8_SA(b, h) (((b) * 2 + (h)) * HTB)
#define PG8_SB(b, h) ((4 + (b) * 2 + (h)) * HTB)
#define PG8_STAGE(bufoff, gbase, voff) do { _Pragma("unroll") for (int _i = 0; _i < 2; ++_i) \
        __builtin_amdgcn_global_load_lds((const unsigned*)((const char*)(gbase) + (voff)[_i]), (PG8_LAS unsigned*)(lds + (bufoff) + ldsw + _i * 8192), 16, 0, 0); } while (0)
#define PG8_LDA(dst, b, h) do { _Pragma("unroll") for (int m = 0; m < 4; ++m) _Pragma("unroll") for (int k = 0; k < 2; ++k) dst[m][k] = *(const PG8_LAS bf16x8*)(lds + PG8_SA(b, h) + aoff + m * 2048 + k * 1024); } while (0)
#define PG8_LDB(dst, b, h) do { _Pragma("unroll") for (int n = 0; n < 2; ++n) _Pragma("unroll") for (int k = 0; k < 2; ++k) dst[n][k] = *(const PG8_LAS bf16x8*)(lds + PG8_SB(b, h) + boff + n * 2048 + k * 1024); } while (0)
#define PG8_MMA(ai, bj, At, Bt) do { __builtin_amdgcn_s_setprio(1); _Pragma("unroll") for (int m = 0; m < 4; ++m) _Pragma("unroll") for (int n = 0; n < 2; ++n) _Pragma("unroll") for (int k = 0; k < 2; ++k) \
        acc[ai][bj][m][n] = __builtin_amdgcn_mfma_f32_16x16x32_bf16(Bt[n][k], At[m][k], acc[ai][bj][m][n], 0, 0, 0); __builtin_amdgcn_s_setprio(0); } while (0)
#define PG8_WAIT_V(n) asm volatile("s_waitcnt vmcnt(" #n ")" ::: "memory")
#define PG8_WAIT_L(n) asm volatile("s_waitcnt lgkmcnt(" #n ")" ::: "memory")
#define PG8_BAR __builtin_amdgcn_s_barrier()
#define PG8_SCHED __builtin_amdgcn_sched_barrier(0)
    Unit cur, nxt; int ui = 0;
    if (!S.next(0, cur)) return;
    f32x4 acc[2][2][4][2];
#pragma unroll
    for (int a = 0; a < 2; ++a)
#pragma unroll
        for (int b = 0; b < 2; ++b)
#pragma unroll
            for (int m = 0; m < 4; ++m)
#pragma unroll
                for (int n = 0; n < 2; ++n) acc[a][b][m][n] = (f32x4){0.f, 0.f, 0.f, 0.f};
    bf16x8 At[4][2], B0[2][2], B1[2][2];
    const char* cA = (const char*)g.A + (size_t)cur.pm * tstep + (size_t)cur.kt0 * kstep; const char* cB = (const char*)g.Bt + (size_t)cur.pn * tstep + (size_t)cur.kt0 * kstep;
    S.a_ready(cur);
    PG8_STAGE(PG8_SB(0, 0), cB, voffB); PG8_STAGE(PG8_SA(0, 0), cA, voffA); PG8_STAGE(PG8_SB(0, 1), cB + hstep, voffB); PG8_STAGE(PG8_SA(0, 1), cA + hstep, voffA);
    if (wr == 1) PG8_BAR;
    PG8_WAIT_V(4); PG8_BAR;
    PG8_STAGE(PG8_SB(1, 0), cB + kstep, voffB); PG8_STAGE(PG8_SA(1, 0), cA + kstep, voffA); PG8_STAGE(PG8_SB(1, 1), cB + hstep + kstep, voffB);
    PG8_WAIT_V(6); PG8_BAR;
    PG8_STAMP();
    for (;;) {
        const bool has_next = S.next(ui + 1, nxt);
        const char* nA = has_next ? (const char*)g.A + (size_t)nxt.pm * tstep + (size_t)nxt.kt0 * kstep : cA; const char* nB = has_next ? (const char*)g.Bt + (size_t)nxt.pn * tstep + (size_t)nxt.kt0 * kstep : cB;
        const int unt = cur.nkt ? cur.nkt : nt;
        for (int t = 0; t < unt; t += 2) {
            if constexpr (Epi::MIDK) { if (t == (nt >> 1) && cur.nkt == 0) E.midk(acc, cur, wr, fr); }
            const bool last = (t == unt - 2);
            const char* a1 = cA + (size_t)(t + 1) * kstep;
            const char* a2 = last ? nA : cA + (size_t)(t + 2) * kstep; const char* b2 = last ? nB : cB + (size_t)(t + 2) * kstep;
            const char* a3 = a2 + kstep; const char* b3 = b2 + kstep;
            if (last && has_next) S.a_ready(nxt);
            PG8_LDB(B0, 0, 0); PG8_SCHED; PG8_LDA(At, 0, 0); PG8_STAGE(PG8_SA(1, 1), a1 + hstep, voffA);
            PG8_WAIT_L(8); PG8_BAR; PG8_WAIT_L(0); PG8_MMA(0, 0, At, B0); PG8_BAR; PG8_SCHED;
            PG8_LDB(B1, 0, 1); PG8_STAGE(PG8_SB(0, 0), b2, voffB);
            PG8_BAR; PG8_WAIT_L(0); PG8_MMA(0, 1, At, B1); PG8_BAR;
            PG8_LDA(At, 0, 1); PG8_STAGE(PG8_SA(0, 0), a2, voffA);
            PG8_BAR; PG8_WAIT_L(0); PG8_MMA(1, 0, At, B0); PG8_BAR; PG8_SCHED;
            PG8_STAGE(PG8_SB(0, 1), b2 + hstep, voffB);
            PG8_WAIT_V(6); PG8_BAR; PG8_MMA(1, 1, At, B1); PG8_BAR;
            PG8_LDB(B0, 1, 0); PG8_SCHED; PG8_LDA(At, 1, 0); PG8_STAGE(PG8_SA(0, 1), a2 + hstep, voffA);
            PG8_WAIT_L(8); PG8_BAR; PG8_WAIT_L(0); PG8_MMA(0, 0, At, B0); PG8_BAR; PG8_SCHED;
            PG8_LDB(B1, 1, 1); PG8_STAGE(PG8_SB(1, 0), b3, voffB);
            PG8_BAR; PG8_WAIT_L(0); PG8_MMA(0, 1, At, B1); PG8_BAR;
            PG8_LDA(At, 1, 1); PG8_STAGE(PG8_SA(1, 0), a3, voffA);
            PG8_BAR; PG8_WAIT_L(0); PG8_MMA(1, 0, At, B0); PG8_BAR; PG8_SCHED;
            PG8_STAGE(PG8_SB(1, 1), b3 + hstep, voffB);
            PG8_WAIT_V(6); PG8_BAR; PG8_MMA(1, 1, At, B1); PG8_BAR;
        }
        PG8_STAMP();
        if constexpr (!Epi::AFTER_DRAIN) { E(acc, cur, wr, wc, fr, fq); S.done(cur); }
        PG8_STAMP();
        if (!has_next) break;
#pragma unroll
        for (int a = 0; a < 2; ++a)
#pragma unroll
            for (int b = 0; b < 2; ++b)
#pragma unroll
                for (int m = 0; m < 4; ++m)
#pragma unroll
                    for (int n = 0; n < 2; ++n) acc[a][b][m][n] = (f32x4){0.f, 0.f, 0.f, 0.f};
        cur = nxt; cA = nA; cB = nB; ++ui;
    }
    PG8_WAIT_V(0);
    if (wr == 0) PG8_BAR;
    PG8_BAR;
    if constexpr (Epi::AFTER_DRAIN) { E.fused(acc, cur, wr, wc, fr, fq, lds, wid, lane); S.done(cur); }
    PG8_STAMP();
    if (STAMP && wid == 0) { stamps[lane] = lane < nts ? (((unsigned long long)(unsigned)ts_hi << 32) | (unsigned)ts_lo) : 0ull;
        if (lane == 62) stamps[62] = rt_entry; if (lane == 63) stamps[63] = (unsigned long long)wall_clock64(); }
#undef PG8_STAMP
#undef PG8_SA
#undef PG8_SB
#undef PG8_STAGE
#undef PG8_LDA
#undef PG8_LDB
#undef PG8_MMA
#undef PG8_WAIT_V
#undef PG8_WAIT_L
#undef PG8_BAR
#undef PG8_SCHED
}
}

using pg8::bf16_t; using pg8::f32x4; using pg8::u32x4; using pg8::u32x2; using pg8::bf16x8;
using pg8::gelu_tanh; using pg8::DM; using pg8::MROWS; using pg8::NPROMPT; using pg8::DIN; using pg8::DFF; using pg8::DUP; using pg8::DA; using pg8::EPS;
#define LAS __attribute__((address_space(3)))
typedef float f32x16 __attribute__((ext_vector_type(16)));
typedef short s16x4 __attribute__((ext_vector_type(4)));
constexpr int NTHREADS = 512, NWAVES = 8;
constexpr int LDS_BYTES = 131072 + 2048 + 8 * 192 * 4;
constexpr int NBLK64 = MROWS / 64;

constexpr size_t MiB = 1u << 20;
constexpr size_t WS_SS = 0;
constexpr size_t WS_WSB = 1 * MiB;
constexpr size_t WS_RAB = 1536 * 1024;
constexpr size_t WS_WIN = 2 * MiB;
constexpr size_t WS_WOUT = WS_WIN + 2 * 20 * MiB;
constexpr size_t WS_WUP = WS_WOUT + 2 * 8 * MiB;
constexpr size_t WS_WDN = WS_WUP + 2 * 44 * MiB;
constexpr size_t WS_XB = WS_WDN + 2 * 22 * MiB;
constexpr size_t WS_SB = WS_XB + 130 * MiB;
constexpr size_t WS_PROJ = WS_SB + 90 * MiB;
constexpr size_t WS_MIX = WS_PROJ + 325 * MiB;
constexpr size_t WS_ACT = WS_PROJ;
constexpr size_t WS_PART = WS_MIX + 130 * MiB;
constexpr size_t WS_END = WS_PART + 44 * MiB;
static_assert((size_t)MROWS * DIN * 2 <= 325 * MiB && (size_t)MROWS * DM * 2 <= 130 * MiB && (size_t)MROWS * DFF * 2 <= 455 * MiB && (size_t)NBLK64 * 4 * DUP * 4 <= 90 * MiB, "ws map");
static_assert(WS_END <= (size_t)1024 * MiB, "ws map fits 1 GiB");
constexpr size_t O_Y = 0, O_PS = (size_t)MROWS * DM, O_PF = O_PS + 2 * 2 * 2 * 1024, O_SV = O_PF + 2 * 2 * 2 * DUP, O_SS = O_SV + 2 * 8 * 64 * 1024, O_SF = O_SS + 2 * 8 * 2 * 1024, O_END = O_SF + 2 * 8 * 2 * DUP;

struct Params { const float* in[18]; float* out; unsigned char* ws; int ph_lo, ph_hi; };
typedef const Params __attribute__((address_space(4)))* CParams;
__device__ __forceinline__ CParams params() { CParams p = (CParams)__builtin_amdgcn_kernarg_segment_ptr(); asm volatile("" : "+s"(p)); return p; }

__device__ __forceinline__ float wave_sum(float v) {
#pragma unroll
    for (int o = 1; o < 64; o <<= 1) v += __shfl_xor(v, o);
    return v;
}
__device__ __forceinline__ unsigned f2bf(float f) { unsigned u = __builtin_bit_cast(unsigned, f); return (u + 0x7fffu + ((u >> 16) & 1u)) >> 16; }
__device__ __forceinline__ unsigned pk2(float lo, float hi) { return f2bf(lo) | (f2bf(hi) << 16); }

__device__ __forceinline__ void transpose_item(const float* W, int K, int N, bf16_t* WT, const float* gk, int interleave, LAS float* scr, int item, int lane) {
    const int nblk = N / 32, kb = item / nblk, nb = item % nblk, k0 = 64 * kb, n0 = 32 * nb;
    const float* src = W + (size_t)(k0 + (lane >> 5)) * N + n0 + (lane & 31);
    float w[32];
#pragma unroll
    for (int i = 0; i < 32; ++i) w[i] = src[(size_t)(2 * i) * N];
    const int c = lane & 7;
    f32x4 ga = {1.f, 1.f, 1.f, 1.f}, gb = ga;
    if (gk) { ga = *(const f32x4*)(gk + k0 + 8 * c); gb = *(const f32x4*)(gk + k0 + 8 * c + 4); }
#pragma unroll
    for (int i = 0; i < 32; ++i) scr[(2 * i + (lane >> 5)) * 33 + (lane & 31)] = w[i];
    asm volatile("s_waitcnt lgkmcnt(0)" ::: "memory");
    int drow0 = n0;
    if (interleave == 1) drow0 = n0 < DFF ? (n0 / 128) * 256 + (n0 % 128) : ((n0 - DFF) / 128) * 256 + 128 + ((n0 - DFF) % 128);
    if (interleave == 2 && n0 >= 3072) { const int n1 = n0 - 3072; drow0 = 3072 + (n1 < 1024 ? (n1 / 128) * 256 + (n1 % 128) : ((n1 - 1024) / 128) * 256 + 128 + ((n1 - 1024) % 128)); }
#pragma unroll
    for (int j = 0; j < 4; ++j) { const int n = (lane >> 3) + 8 * j; const LAS float* s = scr + (8 * c) * 33 + n;
        u32x4 o; o.x = pk2(s[0 * 33] * ga[0], s[1 * 33] * ga[1]); o.y = pk2(s[2 * 33] * ga[2], s[3 * 33] * ga[3]); o.z = pk2(s[4 * 33] * gb[0], s[5 * 33] * gb[1]); o.w = pk2(s[6 * 33] * gb[2], s[7 * 33] * gb[3]);
        *(u32x4*)(WT + (size_t)(drow0 + n) * K + k0 + 8 * c) = o; }
    asm volatile("s_waitcnt lgkmcnt(0)" ::: "memory");
}

constexpr int I_IN = (DM / 64) * (DIN / 32), I_OUT = (DM / 64) * (DM / 32), I_UP = (DM / 64) * (DUP / 32), I_DN = (DFF / 64) * (DM / 32), I_L = I_IN + I_OUT + I_UP + I_DN;
__device__ __forceinline__ void convert_weights(LAS unsigned char* lds, CParams P, int l, int r0, int r1, int worker, int nworkers) {
    int tid_ = threadIdx.x; asm volatile("" : "+v"(tid_));
    const int tid = tid_, lane = tid & 63, wave = tid >> 6;
    unsigned char* ws = P->ws;
    LAS float* scr = (LAS float*)(lds + wave * 16384);
    for (int it = r0 + worker * NWAVES + wave; it < r1; it += nworkers * NWAVES) {
        int r = it;
        if (r < I_IN) { transpose_item(P->in[5] + (size_t)l * DM * DIN, DM, DIN, (bf16_t*)(ws + WS_WIN + l * 20 * MiB), P->in[4] + l * DM, 2, scr, r, lane); continue; } r -= I_IN;
        if (r < I_OUT) { const int k0 = 64 * (r / (DM / 32)); const float* g = k0 < DA ? P->in[10] + l * DA : P->in[11] + l * DA - DA;
            transpose_item(P->in[12] + (size_t)l * DM * DM, DM, DM, (bf16_t*)(ws + WS_WOUT + l * 8 * MiB), g, 0, scr, r, lane); continue; } r -= I_OUT;
        if (r < I_UP) { transpose_item(P->in[14] + (size_t)l * DM * DUP, DM, DUP, (bf16_t*)(ws + WS_WUP + l * 44 * MiB), P->in[13] + l * DM, 1, scr, r, lane); continue; } r -= I_UP;
        transpose_item(P->in[16] + (size_t)l * DFF * DM, DFF, DM, (bf16_t*)(ws + WS_WDN + l * 22 * MiB), nullptr, 0, scr, r, lane);
    }
}

__device__ __forceinline__ void prologue_phase(LAS unsigned char* lds, CParams P) {
    int tid_ = threadIdx.x; asm volatile("" : "+v"(tid_));
    const int tid = tid_, lane = tid & 63, wave = tid >> 6;
    const int gw = blockIdx.x * NWAVES + wave, NGW = gridDim.x * NWAVES;
    unsigned char* ws = P->ws;
    LAS float* scr = (LAS float*)(lds + wave * 16384);
    if (gridDim.x == 256) convert_weights(lds, P, 0, 0, I_IN, blockIdx.x, gridDim.x);
    else { convert_weights(lds, P, 0, 0, I_L, blockIdx.x, gridDim.x); convert_weights(lds, P, 1, 0, I_L, blockIdx.x, gridDim.x); }
    float* ss = (float*)(ws + WS_SS); bf16_t* xb = (bf16_t*)(ws + WS_XB);
    for (int m = gw; m < MROWS; m += NGW) {
        const float* xr = m < NPROMPT ? P->in[0] + (size_t)m * DM : P->in[1] + (size_t)(m - NPROMPT) * DM;
        f32x4 v[8]; float s = 0.f;
#pragma unroll
        for (int j = 0; j < 8; ++j) { v[j] = ((const f32x4*)xr)[lane + 64 * j]; s += (v[j][0] * v[j][0] + v[j][1] * v[j][1]) + (v[j][2] * v[j][2] + v[j][3] * v[j][3]); }
        s = wave_sum(s); if (lane == 0) ss[m] = s;
#pragma unroll
        for (int j = 0; j < 8; ++j) { u32x2 w; w.x = pk2(v[j][0], v[j][1]); w.y = pk2(v[j][2], v[j][3]); ((u32x2*)(xb + (size_t)m * DM))[lane + 64 * j] = w; }
    }
    const int gt = blockIdx.x * NTHREADS + tid, NGT = gridDim.x * NTHREADS;
    for (int i = gt; i < 4 * MROWS; i += NGT) ss[MROWS + i] = 0.f;
    bf16_t* wsb = (bf16_t*)(ws + WS_WSB);
    for (int i = gt; i < 2 * 8 * 128 * 128 / 2; i += NGT) { const float2 w = ((const float2*)P->in[7])[i]; ((unsigned*)wsb)[i] = pk2(w.x, w.y); }
}

__device__ __forceinline__ void pl32swap(unsigned& a, unsigned& b) { const auto r = __builtin_amdgcn_permlane32_swap(a, b, false, false); a = r[0]; b = r[1]; }
__device__ __forceinline__ unsigned off_b(unsigned row, unsigned ch) { return 256u * row + 16u * (ch ^ (((row & 3) << 2) | ((row >> 2) & 3))); }
__device__ __forceinline__ unsigned tr_read_addr(unsigned lane, unsigned c, unsigned ks, unsigned t) {
    const unsigned h = lane >> 5, blk = (lane >> 4) & 1, q = (lane & 15) >> 2, p = lane & 3;
    return off_b(16 * ks + 8 * h + 4 * t + q, 4 * c + 2 * blk + (p >> 1)) + 8 * (p & 1);
}
__device__ __forceinline__ void mixer_phase(LAS unsigned char* lds, CParams P, int l) {
    int tid_ = threadIdx.x; asm volatile("" : "+v"(tid_));
    const int tid = tid_, lane = tid & 63, wave = __builtin_amdgcn_readfirstlane(tid >> 6);
    unsigned char* ws = P->ws;
    const bf16_t* proj = (const bf16_t*)(ws + WS_PROJ); bf16_t* mix = (bf16_t*)(ws + WS_MIX);
    const bf16_t* wsb = (const bf16_t*)(ws + WS_WSB) + (size_t)l * 8 * 128 * 128;
    const float* vg = P->in[6] + l * DA; const float* bs = P->in[8] + l * 8 * 128; const float* scw = P->in[9] + l * 3 * 1024; const float* st_s = P->in[2] + (size_t)l * 8 * 2 * 1024;
    float* oSV = P->out + O_SV + (size_t)l * 8 * 64 * 1024; float* oPS = P->out + O_PS + (size_t)l * 2 * 2 * 1024; float* oSS = P->out + O_SS + (size_t)l * 8 * 2 * 1024;
    LAS float* SSA = (LAS float*)(lds + 65536);
    LAS float* SSB = (LAS float*)(lds + 65536 + 2048);
    LAS float* RA = (LAS float*)(lds + 65536 + 3072);
    LAS float* RB = (LAS float*)(lds + 65536 + 3584);
    const unsigned ldsbase = (unsigned)(size_t)lds;
    const int tb = wave & 3, dh = wave >> 2;
    for (int cu = blockIdx.x; cu < MROWS / 128; cu += gridDim.x) {
        const int row0 = cu * 128; const bool sample = row0 >= NPROMPT;
        float ssA = 0.f;
        const int wt0 = sample ? 32 * (tb & 1) : 32 * tb;
        const int ks_lo = (sample && tb >= 2) ? 4 : 0, ks_hi = (tb >= 2) ? 8 : 4, wcs = (sample && tb >= 2) ? -64 : 0;
        const int t_abs = row0 + 32 * tb + (lane & 31);
        const int tpos = sample ? ((32 * tb + (lane & 31)) & 63) : (32 * tb + (lane & 31));
        const int ch = tid & 15;
        u32x4 raw[4]; f32x4 vga, vgb;
#pragma unroll
        for (int i = 0; i < 4; ++i) raw[i] = *(const u32x4*)(proj + pg8::proj_off(row0 + (tid >> 4) + 32 * i, 1024 + 8 * ch));
        vga = *(const f32x4*)(vg + 8 * ch); vgb = *(const f32x4*)(vg + 8 * ch + 4);
        for (int h = 0; h < 8; ++h) {
            LAS unsigned char* img = lds + (h & 1) * 32768; const unsigned imgbase = ldsbase + (h & 1) * 32768;
            bf16x8 wf[8];
            const bf16_t* wrow = wsb + ((size_t)(h * 128 + wt0 + (lane & 31))) * 128 + wcs + 8 * (lane >> 5);
#pragma unroll
            for (int ks = 0; ks < 8; ++ks) if (ks >= ks_lo && ks < ks_hi) wf[ks] = *(const bf16x8*)(wrow + 16 * ks);
            u32x4 ul[2][2];
#pragma unroll
            for (int nb = 0; nb < 2; ++nb)
#pragma unroll
                for (int p = 0; p < 2; ++p) ul[nb][p] = *(const u32x4*)(proj + pg8::proj_off(t_abs, 128 * h + 32 * (2 * dh + nb) + 16 * p + 8 * (lane >> 5)));
            const float bias = bs[h * 128 + tpos];
            const int hn = h < 7 ? h + 1 : 7;
            u32x4 rawn[4]; f32x4 vgan, vgbn;
#pragma unroll
            for (int i = 0; i < 4; ++i) rawn[i] = *(const u32x4*)(proj + pg8::proj_off(row0 + (tid >> 4) + 32 * i, 1024 + 128 * hn + 8 * ch));
            vgan = *(const f32x4*)(vg + 128 * hn + 8 * ch); vgbn = *(const f32x4*)(vg + 128 * hn + 8 * ch + 4);
#pragma unroll
            for (int i = 0; i < 4; ++i) { const int row = (tid >> 4) + 32 * i; const u32x4 rw = raw[i];
                float g[8]; g[0] = gelu_tanh(pg8::bf_lo(rw.x)); g[1] = gelu_tanh(pg8::bf_hi(rw.x)); g[2] = gelu_tanh(pg8::bf_lo(rw.y)); g[3] = gelu_tanh(pg8::bf_hi(rw.y));
                g[4] = gelu_tanh(pg8::bf_lo(rw.z)); g[5] = gelu_tanh(pg8::bf_hi(rw.z)); g[6] = gelu_tanh(pg8::bf_lo(rw.w)); g[7] = gelu_tanh(pg8::bf_hi(rw.w));
                float s = 0.f;
#pragma unroll
                for (int j = 0; j < 8; ++j) s += g[j] * g[j];
                s += __shfl_xor(s, 1); s += __shfl_xor(s, 2); s += __shfl_xor(s, 4); s += __shfl_xor(s, 8);
                const float rn = pg8::rs_of(s, 1.0f / 128.0f);
                f32x4 o0, o1;
#pragma unroll
                for (int j = 0; j < 4; ++j) { o0[j] = g[j] * rn * vga[j]; o1[j] = g[4 + j] * rn * vgb[j]; }
                if (sample) { float* d = oSV + (size_t)(row0 + row - NPROMPT) * 1024 + 128 * h + 8 * ch; *(f32x4*)d = o0; *(f32x4*)(d + 4) = o1; }
                u32x4 w; w.x = pg8::cvt_pk_bf16(o0[0], o0[1]); w.y = pg8::cvt_pk_bf16(o0[2], o0[3]); w.z = pg8::cvt_pk_bf16(o1[0], o1[1]); w.w = pg8::cvt_pk_bf16(o1[2], o1[3]);
                *(LAS u32x4*)(img + off_b(row, ch)) = w; }
            __syncthreads();
            f32x16 acc[2];
#pragma unroll
            for (int nb = 0; nb < 2; ++nb)
#pragma unroll
                for (int r = 0; r < 16; ++r) acc[nb][r] = 0.f;
            const unsigned a00 = imgbase + tr_read_addr(lane, 2 * dh, 0, 0), a01 = imgbase + tr_read_addr(lane, 2 * dh, 0, 1);
            const unsigned a10 = imgbase + tr_read_addr(lane, 2 * dh + 1, 0, 0), a11 = imgbase + tr_read_addr(lane, 2 * dh + 1, 0, 1);
#pragma unroll
            for (int ks = 0; ks < 8; ++ks) if (ks >= ks_lo && ks < ks_hi) {
                s16x4 f00, f01, f10, f11; const unsigned ko = 4096u * ks;
                asm volatile("ds_read_b64_tr_b16 %0, %4\n\tds_read_b64_tr_b16 %1, %5\n\tds_read_b64_tr_b16 %2, %6\n\tds_read_b64_tr_b16 %3, %7\n\ts_waitcnt lgkmcnt(0)"
                             : "=&v"(f00), "=&v"(f01), "=&v"(f10), "=&v"(f11) : "v"(a00 + ko), "v"(a01 + ko), "v"(a10 + ko), "v"(a11 + ko) : "memory");
                const bf16x8 fa = __builtin_shufflevector(f00, f01, 0, 1, 2, 3, 4, 5, 6, 7), fb = __builtin_shufflevector(f10, f11, 0, 1, 2, 3, 4, 5, 6, 7);
                acc[0] = __builtin_amdgcn_mfma_f32_32x32x16_bf16(fa, wf[ks], acc[0], 0, 0, 0);
                acc[1] = __builtin_amdgcn_mfma_f32_32x32x16_bf16(fb, wf[ks], acc[1], 0, 0, 0);
            }
#pragma unroll
            for (int nb = 0; nb < 2; ++nb)
#pragma unroll
                for (int p = 0; p < 2; ++p) { unsigned l0 = ul[nb][p].x, l1 = ul[nb][p].y, l2 = ul[nb][p].z, l3 = ul[nb][p].w;
                    pl32swap(l0, l2); pl32swap(l1, l3);
                    unsigned w0_[2], w1_[2];
#pragma unroll
                    for (int k = 0; k < 2; ++k) { const int rq = 2 * p + k; const unsigned r0_ = k ? l2 : l0, r1_ = k ? l3 : l1;
                        const float a0 = gelu_tanh(pg8::bf_lo(r0_)) * (acc[nb][4 * rq + 0] + bias), a1 = gelu_tanh(pg8::bf_hi(r0_)) * (acc[nb][4 * rq + 1] + bias);
                        const float a2 = gelu_tanh(pg8::bf_lo(r1_)) * (acc[nb][4 * rq + 2] + bias), a3 = gelu_tanh(pg8::bf_hi(r1_)) * (acc[nb][4 * rq + 3] + bias);
                        ssA += (a0 * a0 + a1 * a1) + (a2 * a2 + a3 * a3);
                        w0_[k] = pg8::cvt_pk_bf16(a0, a1); w1_[k] = pg8::cvt_pk_bf16(a2, a3); }
                    pl32swap(w0_[0], w0_[1]); pl32swap(w1_[0], w1_[1]);
                    u32x4 w4; w4.x = w0_[0]; w4.y = w1_[0]; w4.z = w0_[1]; w4.w = w1_[1];
                    *(u32x4*)(mix + (size_t)t_abs * DM + 128 * h + 32 * (2 * dh + nb) + 16 * p + 8 * (lane >> 5)) = w4; }
#pragma unroll
            for (int i = 0; i < 4; ++i) raw[i] = rawn[i];
            vga = vgan; vgb = vgbn;
        }
        SSA[(dh * 2 + (lane >> 5)) * 128 + 32 * tb + (lane & 31)] = ssA;
        {
            const int cgp = tid & 127, strip = tid >> 7, c0 = 8 * cgp, r0 = row0 + 32 * strip;
            float w0[8], w1[8], w2[8], q1[8], q2[8];
#pragma unroll
            for (int j = 0; j < 8; ++j) { w0[j] = scw[c0 + j]; w1[j] = scw[1024 + c0 + j]; w2[j] = scw[2048 + c0 + j]; }
            const bool seqstart = sample ? ((strip & 1) == 0) : (strip == 0 && (cu & 127) == 0);
            const int sb_ = sample ? (r0 - NPROMPT) / 64 : 0;
            if (seqstart) {
                if (sample) {
#pragma unroll
                    for (int j = 0; j < 8; ++j) { q2[j] = st_s[(sb_ * 2 + 0) * 1024 + c0 + j]; q1[j] = st_s[(sb_ * 2 + 1) * 1024 + c0 + j]; }
                } else {
#pragma unroll
                    for (int j = 0; j < 8; ++j) { q2[j] = 0.f; q1[j] = 0.f; }
                }
            } else {
                const u32x4 c2 = *(const u32x4*)(proj + pg8::proj_off(r0 - 2, 3072 + c0)), c1 = *(const u32x4*)(proj + pg8::proj_off(r0 - 1, 3072 + c0)); const u32x4 h2 = {0x3f803f80u, 0x3f803f80u, 0x3f803f80u, 0x3f803f80u}, h1 = h2;
                q2[0] = pg8::bf_lo(c2.x) * pg8::bf_lo(h2.x); q2[1] = pg8::bf_hi(c2.x) * pg8::bf_hi(h2.x); q2[2] = pg8::bf_lo(c2.y) * pg8::bf_lo(h2.y); q2[3] = pg8::bf_hi(c2.y) * pg8::bf_hi(h2.y);
                q2[4] = pg8::bf_lo(c2.z) * pg8::bf_lo(h2.z); q2[5] = pg8::bf_hi(c2.z) * pg8::bf_hi(h2.z); q2[6] = pg8::bf_lo(c2.w) * pg8::bf_lo(h2.w); q2[7] = pg8::bf_hi(c2.w) * pg8::bf_hi(h2.w);
                q1[0] = pg8::bf_lo(c1.x) * pg8::bf_lo(h1.x); q1[1] = pg8::bf_hi(c1.x) * pg8::bf_hi(h1.x); q1[2] = pg8::bf_lo(c1.y) * pg8::bf_lo(h1.y); q1[3] = pg8::bf_hi(c1.y) * pg8::bf_hi(h1.y);
                q1[4] = pg8::bf_lo(c1.z) * pg8::bf_lo(h1.z); q1[5] = pg8::bf_hi(c1.z) * pg8::bf_hi(h1.z); q1[6] = pg8::bf_lo(c1.w) * pg8::bf_lo(h1.w); q1[7] = pg8::bf_hi(c1.w) * pg8::bf_hi(h1.w);
            }
            const bool st_out = sample ? ((strip & 1) == 1) : (strip == 3 && (cu & 127) == 127);
            float* st_dst = sample ? oSS + (size_t)sb_ * 2 * 1024 + c0 : oPS + (size_t)(cu >> 7) * 2 * 1024 + c0;
#pragma unroll 4
            for (int i = 0; i < 32; ++i) {
                const bf16_t* pr = proj + pg8::proj_off(r0 + i, 2048 + c0);
                const u32x4 gb = *(const u32x4*)pr, gc = *(const u32x4*)(pr + 8 * 16384);     const u32x4 hi = {0x3f803f80u, 0x3f803f80u, 0x3f803f80u, 0x3f803f80u};
                float q[8], b[8], g[8];
                q[0] = pg8::bf_lo(gc.x) * pg8::bf_lo(hi.x); q[1] = pg8::bf_hi(gc.x) * pg8::bf_hi(hi.x); q[2] = pg8::bf_lo(gc.y) * pg8::bf_lo(hi.y); q[3] = pg8::bf_hi(gc.y) * pg8::bf_hi(hi.y);
                q[4] = pg8::bf_lo(gc.z) * pg8::bf_lo(hi.z); q[5] = pg8::bf_hi(gc.z) * pg8::bf_hi(hi.z); q[6] = pg8::bf_lo(gc.w) * pg8::bf_lo(hi.w); q[7] = pg8::bf_hi(gc.w) * pg8::bf_hi(hi.w);
                g[0] = pg8::bf_lo(gb.x); g[1] = pg8::bf_hi(gb.x); g[2] = pg8::bf_lo(gb.y); g[3] = pg8::bf_hi(gb.y); g[4] = pg8::bf_lo(gb.z); g[5] = pg8::bf_hi(gb.z); g[6] = pg8::bf_lo(gb.w); g[7] = pg8::bf_hi(gb.w);
                float s = 0.f;
#pragma unroll
                for (int j = 0; j < 8; ++j) { b[j] = g[j] * (w0[j] * q2[j] + w1[j] * q1[j] + w2[j] * q[j]); s += b[j] * b[j]; }
                u32x4 w; w.x = pg8::cvt_pk_bf16(b[0], b[1]); w.y = pg8::cvt_pk_bf16(b[2], b[3]); w.z = pg8::cvt_pk_bf16(b[4], b[5]); w.w = pg8::cvt_pk_bf16(b[6], b[7]);
                *(u32x4*)(mix + (size_t)(r0 + i) * DM + 1024 + c0) = w;
                if (st_out && i >= 30) { float* d = st_dst + (i - 30) * 1024; *(f32x4*)d = (f32x4){q[0], q[1], q[2], q[3]}; *(f32x4*)(d + 4) = (f32x4){q[4], q[5], q[6], q[7]}; }
                s = wave_sum(s);
                if (lane == 0) SSB[((tid >> 6) & 1) * 128 + 32 * strip + i] = s;
#pragma unroll
                for (int j = 0; j < 8; ++j) { q2[j] = q1[j]; q1[j] = q[j]; }
            }
        }
        __syncthreads();
        if (tid < 128) { const float ra = pg8::rs_of(SSA[tid] + SSA[128 + tid] + SSA[256 + tid] + SSA[384 + tid], 1.0f / 1024.0f), rb = pg8::rs_of(SSB[tid] + SSB[128 + tid], 1.0f / 1024.0f);
            float2* rab = (float2*)(ws + WS_RAB); rab[row0 + tid] = make_float2(ra / rb, rb); }
        __syncthreads();
    }
}

__device__ __forceinline__ void fixup_phase(CParams P, int l) {
    unsigned char* ws = P->ws; const float* sb = (const float*)(ws + WS_SB); bf16_t* act = (bf16_t*)(ws + WS_ACT);
    const float* cw = P->in[15] + (size_t)l * 3 * DUP; const float* st_f = P->in[3] + (size_t)l * 8 * 2 * DUP;
    int tid_ = threadIdx.x; asm volatile("" : "+v"(tid_));
    const int gt = blockIdx.x * NTHREADS + tid_, NGT = gridDim.x * NTHREADS;
    constexpr int NQ = DFF / 4;
    for (int it = gt; it < NBLK64 * 2 * NQ; it += NGT) {
        const int cq = it % NQ, bj = it / NQ, j = bj & 1, blk = bj >> 1, c = 4 * cq;
        const f32x4 z = {0.f, 0.f, 0.f, 0.f};
        f32x4 xg[4], xv[4];
        const float* s0 = sb + (size_t)blk * 4 * DUP + c;
        xg[2] = *(const f32x4*)s0; xv[2] = *(const f32x4*)(s0 + DFF); xg[3] = *(const f32x4*)(s0 + DUP); xv[3] = *(const f32x4*)(s0 + DUP + DFF);
        if (blk >= 512) { const float* sp = st_f + (size_t)(blk - 512) * 2 * DUP + c; xg[0] = *(const f32x4*)sp; xv[0] = *(const f32x4*)(sp + DFF); xg[1] = *(const f32x4*)(sp + DUP); xv[1] = *(const f32x4*)(sp + DUP + DFF); }
        else if ((blk & 255) == 0) { xg[0] = z; xv[0] = z; xg[1] = z; xv[1] = z; }
        else { const float* sp = s0 - 2 * DUP; xg[0] = *(const f32x4*)sp; xv[0] = *(const f32x4*)(sp + DFF); xg[1] = *(const f32x4*)(sp + DUP); xv[1] = *(const f32x4*)(sp + DUP + DFF); }
        const f32x4 wg0 = *(const f32x4*)(cw + c), wg1 = *(const f32x4*)(cw + DUP + c), wg2 = *(const f32x4*)(cw + 2 * DUP + c);
        const f32x4 wv0 = *(const f32x4*)(cw + DFF + c), wv1 = *(const f32x4*)(cw + DUP + DFF + c), wv2 = *(const f32x4*)(cw + 2 * DUP + DFF + c);
        const f32x4 tg0 = j ? xg[1] : xg[0], tg1 = j ? xg[2] : xg[1], tg2 = j ? xg[3] : xg[2], tv0 = j ? xv[1] : xv[0], tv1 = j ? xv[2] : xv[1], tv2 = j ? xv[3] : xv[2];
        const f32x4 G = wg0 * tg0 + wg1 * tg1 + wg2 * tg2, V = wv0 * tv0 + wv1 * tv1 + wv2 * tv2;
        f32x4 a;
#pragma unroll
        for (int e = 0; e < 4; ++e) a[e] = G[e] * V[e] * pg8::sigmoidf_fast(G[e]);
        u32x2 w; w.x = pg8::cvt_pk_bf16(a[0], a[1]); w.y = pg8::cvt_pk_bf16(a[2], a[3]);
        *(u32x2*)(act + (size_t)(blk * 64 + j) * DFF + c) = w;
    }
    float* oPF = P->out + O_PF + (size_t)l * 2 * 2 * DUP; float* oSF = P->out + O_SF + (size_t)l * 8 * 2 * DUP;
    constexpr int NQ2 = DUP / 4;
    for (int it = gt; it < 10 * 2 * NQ2; it += NGT) { const int cq = it % NQ2, sj = it / NQ2, j = sj & 1, s = sj >> 1;
        const int blk = s < 2 ? 256 * s + 255 : 512 + (s - 2);
        const f32x4 v = *(const f32x4*)(sb + ((size_t)blk * 4 + 2 + j) * DUP + 4 * cq);
        float* d = s < 2 ? oPF + ((size_t)s * 2 + j) * DUP : oSF + ((size_t)(s - 2) * 2 + j) * DUP;
        *(f32x4*)(d + 4 * cq) = v; }
}

__device__ __forceinline__ void finalize_phase(CParams P, int ssidx, int nsplit, bool base_in, bool last) {
    int tid_ = threadIdx.x; asm volatile("" : "+v"(tid_));
    const int tid = tid_, lane = tid & 63, wave = tid >> 6;
    const int gw = blockIdx.x * NWAVES + wave, NGW = gridDim.x * NWAVES;
    float* ss = (float*)(P->ws + WS_SS) + (size_t)ssidx * MROWS; bf16_t* xb = (bf16_t*)(P->ws + WS_XB); float* out = P->out;
    const float* part = (const float*)(P->ws + WS_PART); const float* base = P->in[1];
    for (int ms = gw; ms < MROWS - NPROMPT; ms += NGW) { const int m = NPROMPT + ms;
        f32x4 v[8]; float s = 0.f;
        if (base_in) {
#pragma unroll
            for (int j = 0; j < 8; ++j) v[j] = ((const f32x4*)(base + (size_t)ms * DM))[lane + 64 * j];
        } else {
#pragma unroll
            for (int j = 0; j < 8; ++j) { const u32x2 h = ((const u32x2*)(xb + (size_t)m * DM))[lane + 64 * j]; v[j] = (f32x4){pg8::bf_lo(h.x), pg8::bf_hi(h.x), pg8::bf_lo(h.y), pg8::bf_hi(h.y)}; }
        }
        for (int sl = 0; sl < nsplit; ++sl) { const u32x2* pr = (const u32x2*)((const bf16_t*)part + ((size_t)sl * (MROWS - NPROMPT) + ms) * DM);
#pragma unroll
            for (int j = 0; j < 8; ++j) { const u32x2 h = pr[lane + 64 * j]; v[j] += (f32x4){pg8::bf_lo(h.x), pg8::bf_hi(h.x), pg8::bf_lo(h.y), pg8::bf_hi(h.y)}; } }
#pragma unroll
        for (int j = 0; j < 8; ++j) { if (last) ((f32x4*)(out + (size_t)m * DM))[lane + 64 * j] = v[j]; s += (v[j][0] * v[j][0] + v[j][1] * v[j][1]) + (v[j][2] * v[j][2] + v[j][3] * v[j][3]); }
        s = wave_sum(s); if (lane == 0) ss[m] = s;
        if (!last) {
#pragma unroll
            for (int j = 0; j < 8; ++j) { u32x2 w; w.x = pk2(v[j][0], v[j][1]); w.y = pk2(v[j][2], v[j][3]); ((u32x2*)(xb + (size_t)m * DM))[lane + 64 * j] = w; } }
    }
}

__device__ __forceinline__ void final_phase(CParams P) {
    int tid_ = threadIdx.x; asm volatile("" : "+v"(tid_));
    const int tid = tid_, lane = tid & 63, wave = tid >> 6;
    const int gw = blockIdx.x * NWAVES + wave, NGW = gridDim.x * NWAVES;
    const float* g = P->in[17]; float* out = P->out; const bf16_t* xb = (const bf16_t*)(P->ws + WS_XB);
    f32x4 gv[8];
#pragma unroll
    for (int j = 0; j < 8; ++j) gv[j] = ((const f32x4*)g)[lane + 64 * j];
    for (int m = gw; m < MROWS; m += NGW) { f32x4* xr = (f32x4*)(out + (size_t)m * DM); f32x4 v[8]; float s = 0.f;
#pragma unroll
        for (int j = 0; j < 8; ++j) { const u32x2 h = ((const u32x2*)(xb + (size_t)m * DM))[lane + 64 * j]; v[j] = (f32x4){pg8::bf_lo(h.x), pg8::bf_hi(h.x), pg8::bf_lo(h.y), pg8::bf_hi(h.y)};
            s += (v[j][0] * v[j][0] + v[j][1] * v[j][1]) + (v[j][2] * v[j][2] + v[j][3] * v[j][3]); }
        const float rs = pg8::rs_of(wave_sum(s), 1.0f / DM);
#pragma unroll
        for (int j = 0; j < 8; ++j) xr[lane + 64 * j] = v[j] * rs * gv[j]; }
}

constexpr size_t WS_BAR = 768 * 1024;
#define RLX_AGENT __ATOMIC_RELAXED, __HIP_MEMORY_SCOPE_AGENT
#define XB_TMO      128
#define XB_XCNT(j)  (256  + 64 * (j))
#define XB_XSUB(j)  (1280 + 64 * (j))
#define XB_XGEN(j)  (2304 + 64 * (j))
#define XB_TOP      3328
#define XB_TOPGEN   3392
#define XCD_BAR_WORDS 3456
#define XB_SPIN_CAP (1u << 18)

__device__ __forceinline__ unsigned xb_ld(unsigned* p)              { return __hip_atomic_load(p, __ATOMIC_RELAXED, __HIP_MEMORY_SCOPE_AGENT); }
__device__ __forceinline__ unsigned xb_add(unsigned* p, unsigned v) { return __hip_atomic_fetch_add(p, v, __ATOMIC_RELAXED, __HIP_MEMORY_SCOPE_AGENT); }
__device__ __forceinline__ unsigned xb_xcc_id() { return (unsigned)__builtin_amdgcn_s_getreg((3 << 11) | 20) & 0xFu; }
#define XB_SPIN(cond, bar) do { unsigned _sp = 0; while (cond) { __builtin_amdgcn_s_sleep(1); \
    if ((++_sp & 255u) == 0u) { if (xb_ld(&(bar)[XB_TMO])) break; if (_sp > XB_SPIN_CAP) { atomicAdd(&(bar)[XB_TMO], 1u); break; } } } } while (0)

struct XcdBarrier {
    unsigned* bar; unsigned x;
    volatile LAS unsigned* st;
};

__device__ __forceinline__ XcdBarrier xcd_barrier_post(unsigned* bar, volatile LAS unsigned* st) {
    XcdBarrier b; b.bar = bar; b.x = xb_xcc_id(); b.st = st;
    if (threadIdx.x == 0) (void)xb_add(&bar[XB_XCNT(b.x)], 1u);
    return b;
}
__device__ __forceinline__ void xcd_barrier_complete(unsigned* bar, unsigned x, unsigned& nloc, unsigned& nx) {
    const unsigned G = gridDim.x * gridDim.y * gridDim.z;
    unsigned sum, cnt, mine, sp = 0u;
    for (;;) {
        sum = 0u; cnt = 0u; mine = 0u;
#pragma unroll
        for (unsigned j = 0; j < 16; ++j) { const unsigned c = xb_ld(&bar[XB_XCNT(j)]); sum += c; cnt += (c > 0u) ? 1u : 0u; mine = (j == x) ? c : mine; }
        if (sum == G) break;
        __builtin_amdgcn_s_sleep(1);
        if ((++sp & 255u) == 0u) { if (xb_ld(&bar[XB_TMO])) break; if (sp > XB_SPIN_CAP) { atomicAdd(&bar[XB_TMO], 1u); break; } }
    }
    nloc = mine > 0u ? mine : 1u; nx = cnt > 0u ? cnt : 1u;
}

__device__ __forceinline__ void xcd_barrier(const XcdBarrier& b) {
    asm volatile("s_waitcnt vmcnt(0)" ::: "memory");
    __syncthreads();
    if (threadIdx.x == 0) {
        unsigned* bar = b.bar;
        __builtin_amdgcn_s_waitcnt(0);
        unsigned nloc = b.st[0], nx = b.st[1];
        if (nloc == 0u) { xcd_barrier_complete(bar, b.x, nloc, nx); b.st[0] = nloc; b.st[1] = nx; }
        const unsigned old = xb_add(&bar[XB_XSUB(b.x)], 1u);
        const unsigned gen = old / nloc;
        if (old + 1u == (gen + 1u) * nloc) {
            __builtin_amdgcn_fence(__ATOMIC_RELEASE, "agent");
            asm volatile("s_waitcnt vmcnt(0)" ::: "memory");
            const unsigned og = xb_add(&bar[XB_TOP], 1u);
            const unsigned tg = og / nx;
            if (og + 1u == (tg + 1u) * nx) xb_add(&bar[XB_TOPGEN], 1u);
            else XB_SPIN(xb_ld(&bar[XB_TOPGEN]) == tg, bar);
            __builtin_amdgcn_fence(__ATOMIC_ACQUIRE, "agent");
            xb_add(&bar[XB_XGEN(b.x)], 1u);
            asm volatile("s_waitcnt vmcnt(0)" ::: "memory");
        } else {
            XB_SPIN(xb_ld(&bar[XB_XGEN(b.x)]) == gen, bar);
            __builtin_amdgcn_fence(__ATOMIC_ACQUIRE, "agent");
            asm volatile("s_waitcnt vmcnt(0)" ::: "memory");
        }
    }
    __syncthreads();
}

constexpr int N_PHASES = 14;
__global__ void __launch_bounds__(NTHREADS, 2) mk_fwd(Params Parg) {
    extern __shared__ __attribute__((aligned(16))) unsigned char lds_raw[];
    LAS unsigned char* lds = (LAS unsigned char*)lds_raw;
    cg::grid_group grid = cg::this_grid();
    { CParams P = params(); if (P->ph_lo > P->ph_hi) grid.sync(); }
    volatile LAS unsigned* bst = (volatile LAS unsigned*)(lds + 131072 + 1024);
    if (threadIdx.x < 2) bst[threadIdx.x] = 0u;
    __syncthreads();
    { CParams P = params(); (void)xcd_barrier_post((unsigned*)(P->ws + WS_BAR), bst); }
#ifdef ONLY
#define IN(k) ((k) == ONLY)
#else
#define IN(k) true
#endif
#ifdef USE_CG_SYNC
#define GRID_BAR() grid.sync()
#else
#define GRID_BAR() do { XcdBarrier b_; b_.bar = (unsigned*)(params()->ws + WS_BAR); b_.x = xb_xcc_id(); b_.st = (volatile LAS unsigned*)(lds + 131072 + 1024); xcd_barrier(b_); } while (0)
#endif
#ifndef REP_P0
#define REP_P0 1
#endif
#ifndef REP_MIX
#define REP_MIX 1
#endif
#ifndef REP_G1
#define REP_G1 1
#endif
#ifndef REP_G3
#define REP_G3 1
#endif
    if (IN(0)) { for (int rep = 0; rep < REP_P0; ++rep) { prologue_phase(lds, params()); __syncthreads(); } }
    GRID_BAR();
#ifdef REP_SYNC
    for (int rep = 0; rep < REP_SYNC; ++rep) GRID_BAR();
#endif
#pragma unroll
    for (int l = 0; l < 2; ++l) {
        if (IN(1)) {
            CParams P = params(); unsigned char* ws = P->ws; float* ss = (float*)(ws + WS_SS);
            pg8::Gemm g{(const bf16_t*)(ws + WS_XB), (const bf16_t*)(ws + WS_WIN + l * 20 * MiB), MROWS, DIN, DM}; pg8::StaticOrder S; S.init(MROWS, DIN, gridDim.x, blockIdx.x);
            pg8::EpiProj E{(bf16_t*)(ws + WS_PROJ), ss + (l == 0 ? 0 : 2 * MROWS)};
            for (int rep = 0; rep < REP_G1; ++rep) pg8::gemm_phase<pg8::EpiProj, pg8::StaticOrder>(lds, g, S, E, nullptr);
            if (l == 0 && gridDim.x == 256 && blockIdx.x >= 40) { __syncthreads(); convert_weights(lds, P, 0, I_IN, I_IN + I_OUT + I_UP, blockIdx.x - 40, 216); }
        }
        GRID_BAR();
        if (IN(2)) { for (int rep = 0; rep < REP_MIX; ++rep) { mixer_phase(lds, params(), l); __syncthreads(); }
            if (gridDim.x == 256 && blockIdx.x >= 4) {
                if (l == 0) { convert_weights(lds, params(), 0, I_IN + I_OUT + I_UP, I_L, blockIdx.x - 4, 252); convert_weights(lds, params(), 1, 0, I_IN + I_OUT, blockIdx.x - 4, 252); }
                else convert_weights(lds, params(), 1, I_IN + I_OUT + I_UP, I_L, blockIdx.x - 4, 252); } }
        GRID_BAR();
        if (IN(3)) {
            CParams P = params(); unsigned char* ws = P->ws; float* ss = (float*)(ws + WS_SS); float* out = P->out;
            pg8::Gemm g{(const bf16_t*)(ws + WS_MIX), (const bf16_t*)(ws + WS_WOUT + l * 8 * MiB), MROWS, DM, DM}; pg8::SplitOrder S; S.init(DM, gridDim.x, blockIdx.x, 8, 4);
            pg8::EpiResid<true> E{nullptr, nullptr, nullptr, (bf16_t*)(ws + WS_XB), ss + (1 + 2 * l) * MROWS, (float*)(ws + WS_PART), (const float*)(ws + WS_RAB), 1};
            pg8::gemm_phase<pg8::EpiResid<true>, pg8::SplitOrder>(lds, g, S, E, nullptr);
        }
        GRID_BAR();
        if (IN(4)) finalize_phase(params(), 1 + 2 * l, 8, false, false);
        GRID_BAR();
        if (IN(5)) {
            CParams P = params(); unsigned char* ws = P->ws; float* ss = (float*)(ws + WS_SS);
            pg8::Gemm g{(const bf16_t*)(ws + WS_XB), (const bf16_t*)(ws + WS_WUP + l * 44 * MiB), MROWS, DUP, DM}; pg8::StaticOrder S; S.init(MROWS, DUP, gridDim.x, blockIdx.x);
            pg8::EpiFfn E{(bf16_t*)(ws + WS_ACT), ss + (1 + 2 * l) * MROWS, P->in[15] + (size_t)l * 3 * DUP, (float*)(ws + WS_SB), (LAS float*)(lds + 131072 + 2048)};
            for (int rep = 0; rep < REP_G3; ++rep) pg8::gemm_phase<pg8::EpiFfn, pg8::StaticOrder>(lds, g, S, E, nullptr);
            if (l == 0 && gridDim.x == 256 && blockIdx.x >= 88) { __syncthreads(); convert_weights(lds, P, 1, I_IN + I_OUT, I_IN + I_OUT + I_UP, blockIdx.x - 88, 168); }
        }
        GRID_BAR();
        if (IN(6)) fixup_phase(params(), l);
        GRID_BAR();
        if (IN(7)) {
            CParams P = params(); unsigned char* ws = P->ws; float* ss = (float*)(ws + WS_SS); float* out = P->out;
            pg8::Gemm g{(const bf16_t*)(ws + WS_ACT), (const bf16_t*)(ws + WS_WDN + l * 22 * MiB), MROWS, DM, DFF}; pg8::SplitOrder S; S.init(DM, gridDim.x, blockIdx.x, 11, 8);
            pg8::EpiResid<false> E{nullptr, nullptr, nullptr, (bf16_t*)(ws + WS_XB), l == 0 ? ss + 2 * MROWS : nullptr, (float*)(ws + WS_PART), nullptr, 1};
            pg8::gemm_phase<pg8::EpiResid<false>, pg8::SplitOrder>(lds, g, S, E, nullptr);
        }
        GRID_BAR();
        if (IN(8)) finalize_phase(params(), 2, 11, false, false);
        GRID_BAR();
    }
    if (IN(9)) final_phase(params());
#undef IN
}

extern "C" void kernel_launch(void* const* d_in, const int* in_sizes, int n_in, void* d_out, int out_size, void* d_ws, size_t ws_size, hipStream_t stream) {
    static int grid = 0;
    if (grid == 0) {
        if (n_in != 18 || (size_t)out_size != O_END || ws_size < WS_END) { fprintf(stderr, "kernel_launch: unexpected shapes: n_in %d out %d ws %zu (need %zu)\n", n_in, out_size, ws_size, (size_t)WS_END); grid = -1; return; }
        int dev = 0, cus = 0, per_cu = 0;
        hipGetDevice(&dev); hipDeviceGetAttribute(&cus, hipDeviceAttributeMultiprocessorCount, dev);
        if (hipFuncSetAttribute((const void*)mk_fwd, hipFuncAttributeMaxDynamicSharedMemorySize, LDS_BYTES) != hipSuccess) { fprintf(stderr, "kernel_launch: hipFuncSetAttribute failed\n"); grid = -1; return; }
        if (hipOccupancyMaxActiveBlocksPerMultiprocessor(&per_cu, (const void*)mk_fwd, NTHREADS, LDS_BYTES) != hipSuccess || per_cu < 1) { fprintf(stderr, "kernel_launch: occupancy query says %d\n", per_cu); per_cu = 1; }
        (void)hipGetLastError();
        grid = cus * 1;
        fprintf(stderr, "kernel_launch: grid %d (cus %d, per_cu %d)\n", grid, cus, per_cu);
    }
    if (grid < 0) return;
    if (hipMemsetAsync((char*)d_ws + WS_BAR, 0, 16384, stream) != hipSuccess) { fprintf(stderr, "kernel_launch: memset failed\n"); return; }
    Params p{};
    for (int i = 0; i < 18; ++i) p.in[i] = (const float*)d_in[i];
    p.out = (float*)d_out; p.ws = (unsigned char*)d_ws;
    p.ph_lo = 0; p.ph_hi = 1;
    void* args[] = {&p};
    hipError_t e = hipLaunchCooperativeKernel((const void*)mk_fwd, dim3(grid), dim3(NTHREADS), args, LDS_BYTES, stream);
    if (e != hipSuccess) fprintf(stderr, "kernel_launch: cooperative launch failed: %s (grid %d)\n", hipGetErrorString(e), grid);
}
```

```cpp
#include <hip/hip_runtime.h>
#include <hip/hip_cooperative_groups.h>
#include <cstdio>
namespace cg = cooperative_groups;
namespace pg8 {
#define PG8_LAS __attribute__((address_space(3)))
typedef unsigned short bf16_t;
typedef short bf16x8 __attribute__((ext_vector_type(8)));
typedef float f32x4 __attribute__((ext_vector_type(4)));
typedef unsigned u32x4 __attribute__((ext_vector_type(4)));
constexpr int BM = 256, BK = 64, HALF = 128, HTB = HALF * BK * 2  , STAGE_BYTES = 8 * HTB, NXCD = 8, WGM = 8;

__host__ __device__ __forceinline__ int lds_byte(int r, int c) { const int st = (r >> 4) * 2 + (c >> 5), rr = r & 15, cc = c & 31, ob = rr * 64 + cc * 2; return st * 1024 + (ob ^ (((ob >> 9) & 1) << 5)); }
__host__ __device__ __forceinline__ void stage_rc(int b, int& R, int& C) { const int st = b / 1024, sb = b % 1024, swz = sb ^ (((sb >> 9) & 1) << 5); R = (st >> 1) * 16 + swz / 64; C = (st & 1) * 32 + (swz % 64) / 2; }
__host__ __device__ __forceinline__ int perm32(int rho) { const int n = rho >> 4, i = rho & 15; return 8 * (i >> 2) + 4 * n + (i & 3); }

struct Unit { int pm, pn, kt0, nkt; };
struct Gemm { const bf16_t* A; const bf16_t* Bt; int M, N, K; };

struct StaticOrder {
    int nM, nN, nwg, G, c;
    __host__ __device__ void init(int M, int N, int G_, int c_) { nM = M / BM; nN = N / BM; nwg = nM * nN; G = G_; c = c_; }
    __host__ __device__ bool next(int i, Unit& u) const {
        const long L = (long)i * G + c; if (L >= nwg) return false;
        int wgid = (int)L; { const int q = nwg / NXCD, r = nwg % NXCD, xcd = wgid % NXCD, off = wgid / NXCD; wgid = (xcd < r ? xcd * (q + 1) : r * (q + 1) + (xcd - r) * q) + off; }
        const int nig = WGM * nN, gid = wgid / nig, fm = gid * WGM, gsz = (nM - fm) < WGM ? (nM - fm) : WGM;
        u.pm = fm + ((wgid % nig) % gsz); u.pn = (wgid % nig) / gsz; u.kt0 = 0; u.nkt = 0; return true;
    }
    __device__ __forceinline__ void a_ready(const Unit&) const {}
    __device__ __forceinline__ void done(const Unit&) const {}
};
__device__ __forceinline__ unsigned cvt_pk_bf16(float lo, float hi) { unsigned r; asm volatile("v_cvt_pk_bf16_f32 %0, %1, %2" : "=v"(r) : "v"(lo), "v"(hi)); return r; }
typedef float f32x2 __attribute__((ext_vector_type(2)));

constexpr int DM = 2048, MROWS = 33280, NPROMPT = 32768, DIN = 5120, DFF = 5632, DUP = 11264, DA = 1024;
constexpr float EPS = 1e-6f;
typedef unsigned u32x2 __attribute__((ext_vector_type(2)));
__device__ __forceinline__ float rs_of(float ss, float invn) { return __builtin_amdgcn_rsqf(ss * invn + EPS); }
__device__ __forceinline__ float bf_lo(unsigned w) { return __uint_as_float(w << 16); }
__device__ __forceinline__ float bf_hi(unsigned w) { return __uint_as_float(w & 0xffff0000u); }
__device__ __forceinline__ float sigmoidf_fast(float x) { return __builtin_amdgcn_rcpf(1.0f + __builtin_amdgcn_exp2f(-1.44269504089f * x)); }
__device__ __forceinline__ float gelu_tanh(float x) { const float u = 1.5957691216f * x * (1.0f + 0.044715f * x * x); return x * sigmoidf_fast(u); }
template <int CTRL> __device__ __forceinline__ float dpp_mov(float src) {
    return __builtin_bit_cast(float, __builtin_amdgcn_mov_dpp(__builtin_bit_cast(int, src), CTRL, 0xf, 0xf, true)); }
template <int CTRL> __device__ __forceinline__ float dpp_f(float old, float src) {
    return __builtin_bit_cast(float, __builtin_amdgcn_update_dpp(__builtin_bit_cast(int, old), __builtin_bit_cast(int, src), CTRL, 0xf, 0xf, false)); }

struct SplitOrder {
    StaticOrder base; int nN, nsplit, nkt_item, nitems, G, c;
    __host__ __device__ void init(int N, int G_, int c_, int nsplit_, int nkt_item_) { base.init(NPROMPT, N, G_, c_); nN = N / BM; nsplit = nsplit_; nkt_item = nkt_item_; nitems = ((MROWS - NPROMPT) / BM) * nN * nsplit; G = G_; c = c_; }
    __host__ __device__ bool next(int i, Unit& u) const {
        const int np = c < base.nwg ? (base.nwg - c + G - 1) / G : 0;
        if (i < np) return base.next(i, u);
        const int j = (i - np) * G + c; if (j >= nitems) return false;
        const int tile = j / nsplit; u.pm = NPROMPT / BM + tile / nN; u.pn = tile % nN; u.kt0 = (j % nsplit) * nkt_item; u.nkt = nkt_item; return true;
    }
    __device__ __forceinline__ void a_ready(const Unit&) const {}
    __device__ __forceinline__ void done(const Unit&) const {}
};
__device__ __forceinline__ size_t proj_off(int r, int c) { return ((size_t)(r >> 7) * 32 + (c >> 7)) * 16384 + (size_t)(r & 127) * 128 + (c & 127); }
struct EpiProj {
    static constexpr bool PERM = true, AFTER_DRAIN = false, MIDK = false;
    bf16_t* O; const float* ss;
    __device__ __forceinline__ void operator()(f32x4 (&acc)[2][2][4][2], const Unit& u, int wr, int wc, int fr, int fq) const {
        const int row0 = u.pm * BM + wr * 64 + fr, col0 = u.pn * BM + wc * 32 + 8 * fq;
        float rsv[2][4];
#pragma unroll
        for (int ai = 0; ai < 2; ++ai)
#pragma unroll
            for (int m = 0; m < 4; ++m) rsv[ai][m] = ss[row0 + ai * HALF + m * 16];
#pragma unroll
        for (int ai = 0; ai < 2; ++ai)
#pragma unroll
            for (int m = 0; m < 4; ++m) { const int r = row0 + ai * HALF + m * 16; const float rs = rs_of(rsv[ai][m], 1.0f / DM);
                if (u.pn >= 12) {
                    const float rq = rs * rs; const f32x4 v0 = acc[ai][0][m][0] * acc[ai][1][m][0] * rq, v1 = acc[ai][0][m][1] * acc[ai][1][m][1] * rq;
                    u32x4 w; w.x = cvt_pk_bf16(v0[0], v0[1]); w.y = cvt_pk_bf16(v0[2], v0[3]); w.z = cvt_pk_bf16(v1[0], v1[1]); w.w = cvt_pk_bf16(v1[2], v1[3]);
                    *(u32x4*)(O + proj_off(r, 3072 + (u.pn - 12) * HALF + wc * 32 + 8 * fq)) = w;
                } else {
                bf16_t* rowp = O + proj_off(r, col0);
#pragma unroll
                for (int bj = 0; bj < 2; ++bj) { const f32x4 v0 = acc[ai][bj][m][0] * rs, v1 = acc[ai][bj][m][1] * rs;
                    u32x4 w; w.x = cvt_pk_bf16(v0[0], v0[1]); w.y = cvt_pk_bf16(v0[2], v0[3]); w.z = cvt_pk_bf16(v1[0], v1[1]); w.w = cvt_pk_bf16(v1[2], v1[3]);
                    *(u32x4*)(rowp + bj * 16384) = w; } } }
    }
};
template <bool SCALE> struct EpiResid {
    static constexpr bool PERM = true, AFTER_DRAIN = false, MIDK = SCALE;
    const float* baseP; const float* baseS; float* out; bf16_t* xb; float* ssout; float* part; const float* rab; int wxb;
    __device__ __forceinline__ void midk(f32x4 (&acc)[2][2][4][2], const Unit& u, int wr, int fr) const {
        float q[2][4];
#pragma unroll
        for (int ai = 0; ai < 2; ++ai)
#pragma unroll
            for (int m = 0; m < 4; ++m) q[ai][m] = rab[2 * (u.pm * BM + wr * 64 + fr + ai * HALF + m * 16)];
#pragma unroll
        for (int ai = 0; ai < 2; ++ai)
#pragma unroll
            for (int m = 0; m < 4; ++m)
#pragma unroll
                for (int bj = 0; bj < 2; ++bj)
#pragma unroll
                    for (int n = 0; n < 2; ++n) acc[ai][bj][m][n] *= q[ai][m];
    }
    __device__ __forceinline__ void operator()(f32x4 (&acc)[2][2][4][2], const Unit& u, int wr, int wc, int fr, int fq) const {
        const int row0 = u.pm * BM + wr * 64 + fr, col0 = u.pn * BM + wc * 32 + 8 * fq;
        if (u.nkt) {
            bf16_t* pp = (bf16_t*)part + ((size_t)(u.kt0 / u.nkt) * (MROWS - NPROMPT) + (row0 - NPROMPT)) * DM + col0;
            float f[2][4];
#pragma unroll
            for (int ai = 0; ai < 2; ++ai)
#pragma unroll
                for (int m = 0; m < 4; ++m) { f[ai][m] = 1.0f;
                    if (SCALE) { const float* rp = rab + 2 * (row0 + ai * HALF + m * 16); const float rb = rp[1]; f[ai][m] = u.kt0 < 16 ? rp[0] * rb : rb; } }
#pragma unroll
            for (int ai = 0; ai < 2; ++ai)
#pragma unroll
                for (int m = 0; m < 4; ++m)
#pragma unroll
                    for (int bj = 0; bj < 2; ++bj) { const f32x4 o0 = acc[ai][bj][m][0] * f[ai][m], o1 = acc[ai][bj][m][1] * f[ai][m];
                        u32x4 w; w.x = cvt_pk_bf16(o0[0], o0[1]); w.y = cvt_pk_bf16(o0[2], o0[3]); w.z = cvt_pk_bf16(o1[0], o1[1]); w.w = cvt_pk_bf16(o1[2], o1[3]);
                        *(u32x4*)(pp + (size_t)(ai * HALF + m * 16) * DM + bj * HALF) = w; }
            return;
        }
        const bf16_t* bb = xb + (size_t)row0 * DM + col0;
        u32x4 hb[2][4][2]; float rbv[2][4];
#pragma unroll
        for (int ai = 0; ai < 2; ++ai)
#pragma unroll
            for (int m = 0; m < 4; ++m) {
#pragma unroll
                for (int bj = 0; bj < 2; ++bj) hb[ai][m][bj] = *(const u32x4*)(bb + (size_t)(ai * HALF + m * 16) * DM + bj * HALF);
                rbv[ai][m] = SCALE ? rab[2 * (row0 + ai * HALF + m * 16) + 1] : 1.0f; }
        asm volatile("" ::: "memory");
#pragma unroll
        for (int ai = 0; ai < 2; ++ai)
#pragma unroll
            for (int m = 0; m < 4; ++m) { const int r = row0 + ai * HALF + m * 16; float s = 0.f;
#pragma unroll
                for (int bj = 0; bj < 2; ++bj) { const u32x4 h = hb[ai][m][bj];
                    const f32x4 b0 = {bf_lo(h.x), bf_hi(h.x), bf_lo(h.y), bf_hi(h.y)}, b1 = {bf_lo(h.z), bf_hi(h.z), bf_lo(h.w), bf_hi(h.w)};
                    const f32x4 o0 = SCALE ? acc[ai][bj][m][0] * rbv[ai][m] + b0 : acc[ai][bj][m][0] + b0, o1 = SCALE ? acc[ai][bj][m][1] * rbv[ai][m] + b1 : acc[ai][bj][m][1] + b1;
                    s += ((o0[0] * o0[0] + o0[1] * o0[1]) + (o0[2] * o0[2] + o0[3] * o0[3])) + ((o1[0] * o1[0] + o1[1] * o1[1]) + (o1[2] * o1[2] + o1[3] * o1[3]));
                    u32x4 w; w.x = cvt_pk_bf16(o0[0], o0[1]); w.y = cvt_pk_bf16(o0[2], o0[3]); w.z = cvt_pk_bf16(o1[0], o1[1]); w.w = cvt_pk_bf16(o1[2], o1[3]);
                    *(u32x4*)(xb + (size_t)r * DM + col0 + bj * HALF) = w; }
                s += __shfl_xor(s, 16); s += __shfl_xor(s, 32);
                if (ssout && fq == 0) unsafeAtomicAdd(ssout + r, s); }
    }
};
struct EpiFfn {
    static constexpr bool PERM = true, AFTER_DRAIN = false, MIDK = false;
    bf16_t* act; const float* ss; const float* cw; float* sb; PG8_LAS float* wl;
    __device__ __forceinline__ void operator()(f32x4 (&acc)[2][2][4][2], const Unit& u, int wr, int wc, int fr, int fq) const {
        const int rt0 = wr * 64 + fr, gc0 = u.pn * 128 + wc * 32 + 8 * fq;
        PG8_LAS float* wimg = wl + (wr * 4 + wc) * 192;
        if (fr < 6) { const float* src = cw + (size_t)(fr % 3) * DUP + (fr / 3) * DFF + gc0; const f32x4 w0 = *(const f32x4*)src, w1 = *(const f32x4*)(src + 4);
            *(PG8_LAS f32x4*)(wimg + fr * 32 + 8 * fq) = w0; *(PG8_LAS f32x4*)(wimg + fr * 32 + 8 * fq + 4) = w1; }
        {
            float rsv[2][4];
#pragma unroll
            for (int ai = 0; ai < 2; ++ai)
#pragma unroll
                for (int m = 0; m < 4; ++m) rsv[ai][m] = ss[u.pm * BM + rt0 + ai * HALF + m * 16];
#pragma unroll
            for (int ai = 0; ai < 2; ++ai)
#pragma unroll
                for (int m = 0; m < 4; ++m) { const float rs = rs_of(rsv[ai][m], 1.0f / DM);
#pragma unroll
                    for (int bj = 0; bj < 2; ++bj)
#pragma unroll
                        for (int n = 0; n < 2; ++n) acc[ai][bj][m][n] *= rs; }
        }
#pragma unroll
        for (int ai = 0; ai < 2; ++ai) { const int blk = u.pm * 4 + ai * 2 + wr;
            u32x2 keep[4];
#pragma unroll
            for (int n = 0; n < 2; ++n) { const int gc = gc0 + 4 * n;
                const PG8_LAS float* wq = wimg + 8 * fq + 4 * n;
                const f32x4 wg0 = *(const PG8_LAS f32x4*)wq, wg1 = *(const PG8_LAS f32x4*)(wq + 32), wg2 = *(const PG8_LAS f32x4*)(wq + 64);
                const f32x4 wv0 = *(const PG8_LAS f32x4*)(wq + 96), wv1 = *(const PG8_LAS f32x4*)(wq + 128), wv2 = *(const PG8_LAS f32x4*)(wq + 160);
#pragma unroll
                for (int m = 0; m < 4; ++m) { const f32x4 pg = acc[ai][0][m][n], pv = acc[ai][1][m][n];
                    const f32x4 pgp = acc[ai][0][m ? m - 1 : 0][n], pvp = acc[ai][1][m ? m - 1 : 0][n];
                    f32x4 a;
#pragma unroll
                    for (int h = 0; h < 2; ++h) {
                        f32x2 s1g, s2g, s1v, s2v;
#pragma unroll
                        for (int k = 0; k < 2; ++k) { const int j = 2 * h + k;
                            if (m) { s1g[k] = dpp_f<0x111>(dpp_mov<0x121>(pgp[j]), pg[j]); s2g[k] = dpp_f<0x112>(dpp_mov<0x122>(pgp[j]), pg[j]);
                                     s1v[k] = dpp_f<0x111>(dpp_mov<0x121>(pvp[j]), pv[j]); s2v[k] = dpp_f<0x112>(dpp_mov<0x122>(pvp[j]), pv[j]); }
                            else   { s1g[k] = dpp_mov<0x111>(pg[j]); s2g[k] = dpp_mov<0x112>(pg[j]); s1v[k] = dpp_mov<0x111>(pv[j]); s2v[k] = dpp_mov<0x112>(pv[j]); } }
                        const f32x2 pg2 = {pg[2 * h], pg[2 * h + 1]}, pv2 = {pv[2 * h], pv[2 * h + 1]};
                        const f32x2 G = (f32x2){wg0[2 * h], wg0[2 * h + 1]} * s2g + (f32x2){wg1[2 * h], wg1[2 * h + 1]} * s1g + (f32x2){wg2[2 * h], wg2[2 * h + 1]} * pg2;
                        const f32x2 V = (f32x2){wv0[2 * h], wv0[2 * h + 1]} * s2v + (f32x2){wv1[2 * h], wv1[2 * h + 1]} * s1v + (f32x2){wv2[2 * h], wv2[2 * h + 1]} * pv2;
                        const f32x2 GV = G * V;
                        a[2 * h] = GV[0] * sigmoidf_fast(G[0]); a[2 * h + 1] = GV[1] * sigmoidf_fast(G[1]);
                    }
                    const int r = u.pm * BM + ai * HALF + rt0 + m * 16;
                    { u32x2 w; w.x = cvt_pk_bf16(a[0], a[1]); w.y = cvt_pk_bf16(a[2], a[3]);
                      if (n == 0) keep[m] = w;
                      else if (!(m == 0 && fr < 2)) { u32x4 w4; w4.x = keep[m].x; w4.y = keep[m].y; w4.z = w.x; w4.w = w.y; *(u32x4*)(act + (size_t)r * DFF + gc0) = w4; } }
                    if (m == 0 && fr < 2) { float* p = sb + ((size_t)blk * 4 + fr) * DUP + gc; *(f32x4*)p = pg; *(f32x4*)(p + DFF) = pv; }
                    if (m == 3 && fr >= 14) { float* p = sb + ((size_t)blk * 4 + fr - 12) * DUP + gc; *(f32x4*)p = pg; *(f32x4*)(p + DFF) = pv; }
                }
            }
        }
    }
};
template <class Epi, class Sched, bool STAMP = false>
__device__ __forceinline__ void gemm_phase(PG8_LAS unsigned char* lds, const Gemm g, const Sched& S, const Epi& E, unsigned long long* stamps) {
    int tid_ = threadIdx.x; asm volatile("" : "+v"(tid_));
    const int tid = tid_, wid = __builtin_amdgcn_readfirstlane(tid >> 6), lane = tid & 63, wr = wid >> 2, wc = wid & 3, fr = lane & 15, fq = lane >> 4;
    const int K = g.K, nt = K / BK;
    int ts_lo = 0, ts_hi = 0, nts = 0; const unsigned long long rt_entry = STAMP ? (unsigned long long)wall_clock64() : 0ull;
#define PG8_STAMP() do { if (STAMP && wid == 0 && nts < 64) { const unsigned long long _c = (unsigned long long)clock64(); \
        ts_lo = (lane == nts) ? (int)(unsigned)_c : ts_lo; ts_hi = (lane == nts) ? (int)(unsigned)(_c >> 32) : ts_hi; ++nts; } } while (0)
    PG8_STAMP();
    unsigned voffA[2], voffB[2];
#pragma unroll
    for (int i = 0; i < 2; ++i) { int R, C; stage_rc(tid * 16 + i * 8192, R, C); const int Rb = Epi::PERM ? ((R & ~31) + perm32(R & 31)) : R;
        voffA[i] = (unsigned)(R * K + C) * 2u; voffB[i] = (unsigned)(Rb * K + C) * 2u; }
    const size_t kstep = (size_t)(BK * 2);
    const size_t hstep = (size_t)HALF * K * 2;
    const size_t tstep = 2 * hstep;
    const unsigned ldsw = (unsigned)wid * 1024u;
    const int aoff = lds_byte(wr * 64 + fr, fq * 8), boff = lds_byte(wc * 32 + fr, fq * 8);
#define PG8_SA(b, h) (((b) * 2 + (h)) * HTB)
#define PG8_SB(b, h) ((4 + (b) * 2 + (h)) * HTB)
#define PG8_STAGE(bufoff, gbase, voff) do { _Pragma("unroll") for (int _i = 0; _i < 2; ++_i) \
        __builtin_amdgcn_global_load_lds((const unsigned*)((const char*)(gbase) + (voff)[_i]), (PG8_LAS unsigned*)(lds + (bufoff) + ldsw + _i * 8192), 16, 0, 0); } while (0)
#define PG8_LDA(dst, b, h) do { _Pragma("unroll") for (int m = 0; m < 4; ++m) _Pragma("unroll") for (int k = 0; k < 2; ++k) dst[m][k] = *(const PG8_LAS bf16x8*)(lds + PG8_SA(b, h) + aoff + m * 2048 + k * 1024); } while (0)
#define PG8_LDB(dst, b, h) do { _Pragma("unroll") for (int n = 0; n < 2; ++n) _Pragma("unroll") for (int k = 0; k < 2; ++k) dst[n][k] = *(const PG8_LAS bf16x8*)(lds + PG8_SB(b, h) + boff + n * 2048 + k * 1024); } while (0)
#define PG8_MMA(ai, bj, At, Bt) do { __builtin_amdgcn_s_setprio(1); _Pragma("unroll") for (int m = 0; m < 4; ++m) _Pragma("unroll") for (int n = 0; n < 2; ++n) _Pragma("unroll") for (int k = 0; k < 2; ++k) \
        acc[ai][bj][m][n] = __builtin_amdgcn_mfma_f32_16x16x32_bf16(Bt[n][k], At[m][k], acc[ai][bj][m][n], 0, 0, 0); __builtin_amdgcn_s_setprio(0); } while (0)
#define PG8_WAIT_V(n) asm volatile("s_waitcnt vmcnt(" #n ")" ::: "memory")
#define PG8_WAIT_L(n) asm volatile("s_waitcnt lgkmcnt(" #n ")" ::: "memory")
#define PG8_BAR __builtin_amdgcn_s_barrier()
#define PG8_SCHED __builtin_amdgcn_sched_barrier(0)
    Unit cur, nxt; int ui = 0;
    if (!S.next(0, cur)) return;
    f32x4 acc[2][2][4][2];
#pragma unroll
    for (int a = 0; a < 2; ++a)
#pragma unroll
        for (int b = 0; b < 2; ++b)
#pragma unroll
            for (int m = 0; m < 4; ++m)
#pragma unroll
                for (int n = 0; n < 2; ++n) acc[a][b][m][n] = (f32x4){0.f, 0.f, 0.f, 0.f};
    bf16x8 At[4][2], B0[2][2], B1[2][2];
    const char* cA = (const char*)g.A + (size_t)cur.pm * tstep + (size_t)cur.kt0 * kstep; const char* cB = (const char*)g.Bt + (size_t)cur.pn * tstep + (size_t)cur.kt0 * kstep;
    S.a_ready(cur);
    PG8_STAGE(PG8_SB(0, 0), cB, voffB); PG8_STAGE(PG8_SA(0, 0), cA, voffA); PG8_STAGE(PG8_SB(0, 1), cB + hstep, voffB); PG8_STAGE(PG8_SA(0, 1), cA + hstep, voffA);
    if (wr == 1) PG8_BAR;
    PG8_WAIT_V(4); PG8_BAR;
    PG8_STAGE(PG8_SB(1, 0), cB + kstep, voffB); PG8_STAGE(PG8_SA(1, 0), cA + kstep, voffA); PG8_STAGE(PG8_SB(1, 1), cB + hstep + kstep, voffB);
    PG8_WAIT_V(6); PG8_BAR;
    PG8_STAMP();
    for (;;) {
        const bool has_next = S.next(ui + 1, nxt);
        const char* nA = has_next ? (const char*)g.A + (size_t)nxt.pm * tstep + (size_t)nxt.kt0 * kstep : cA; const char* nB = has_next ? (const char*)g.Bt + (size_t)nxt.pn * tstep + (size_t)nxt.kt0 * kstep : cB;
        const int unt = cur.nkt ? cur.nkt : nt;
        for (int t = 0; t < unt; t += 2) {
            if constexpr (Epi::MIDK) { if (t == (nt >> 1) && cur.nkt == 0) E.midk(acc, cur, wr, fr); }
            const bool last = (t == unt - 2);
            const char* a1 = cA + (size_t)(t + 1) * kstep;
            const char* a2 = last ? nA : cA + (size_t)(t + 2) * kstep; const char* b2 = last ? nB : cB + (size_t)(t + 2) * kstep;
            const char* a3 = a2 + kstep; const char* b3 = b2 + kstep;
            if (last && has_next) S.a_ready(nxt);
            PG8_LDB(B0, 0, 0); PG8_SCHED; PG8_LDA(At, 0, 0); PG8_STAGE(PG8_SA(1, 1), a1 + hstep, voffA);
            PG8_WAIT_L(8); PG8_BAR; PG8_WAIT_L(0); PG8_MMA(0, 0, At, B0); PG8_BAR; PG8_SCHED;
            PG8_LDB(B1, 0, 1); PG8_STAGE(PG8_SB(0, 0), b2, voffB);
            PG8_BAR; PG8_WAIT_L(0); PG8_MMA(0, 1, At, B1); PG8_BAR;
            PG8_LDA(At, 0, 1); PG8_STAGE(PG8_SA(0, 0), a2, voffA);
            PG8_BAR; PG8_WAIT_L(0); PG8_MMA(1, 0, At, B0); PG8_BAR; PG8_SCHED;
            PG8_STAGE(PG8_SB(0, 1), b2 + hstep, voffB);
            PG8_WAIT_V(6); PG8_BAR; PG8_MMA(1, 1, At, B1); PG8_BAR;
            PG8_LDB(B0, 1, 0); PG8_SCHED; PG8_LDA(At, 1, 0); PG8_STAGE(PG8_SA(0, 1), a2 + hstep, voffA);
            PG8_WAIT_L(8); PG8_BAR; PG8_WAIT_L(0); PG8_MMA(0, 0, At, B0); PG8_BAR; PG8_SCHED;
            PG8_LDB(B1, 1, 1); PG8_STAGE(PG8_SB(1, 0), b3, voffB);
            PG8_BAR; PG8_WAIT_L(0); PG8_MMA(0, 1, At, B1); PG8_BAR;
            PG8_LDA(At, 1, 1); PG8_STAGE(PG8_SA(1, 0), a3, voffA);
            PG8_BAR; PG8_WAIT_L(0); PG8_MMA(1, 0, At, B0); PG8_BAR; PG8_SCHED;
            PG8_STAGE(PG8_SB(1, 1), b3 + hstep, voffB);
            PG8_WAIT_V(6); PG8_BAR; PG8_MMA(1, 1, At, B1); PG8_BAR;
        }
        PG8_STAMP();
        if constexpr (!Epi::AFTER_DRAIN) { E(acc, cur, wr, wc, fr, fq); S.done(cur); }
        PG8_STAMP();
        if (!has_next) break;
#pragma unroll
        for (int a = 0; a < 2; ++a)
#pragma unroll
            for (int b = 0; b < 2; ++b)
#pragma unroll
                for (int m = 0; m < 4; ++m)
#pragma unroll
                    for (int n = 0; n < 2; ++n) acc[a][b][m][n] = (f32x4){0.f, 0.f, 0.f, 0.f};
        cur = nxt; cA = nA; cB = nB; ++ui;
    }
    PG8_WAIT_V(0);
    if (wr == 0) PG8_BAR;
    PG8_BAR;
    if constexpr (Epi::AFTER_DRAIN) { E.fused(acc, cur, wr, wc, fr, fq, lds, wid, lane); S.done(cur); }
    PG8_STAMP();
    if (STAMP && wid == 0) { stamps[lane] = lane < nts ? (((unsigned long long)(unsigned)ts_hi << 32) | (unsigned)ts_lo) : 0ull;
        if (lane == 62) stamps[62] = rt_entry; if (lane == 63) stamps[63] = (unsigned long long)wall_clock64(); }
#undef PG8_STAMP
#undef PG8_SA
#undef PG8_SB
#undef PG8_STAGE
#undef PG8_LDA
#undef PG8_LDB
#undef PG8_MMA
#undef PG8_WAIT_V
#undef PG8_WAIT_L
#undef PG8_BAR
#undef PG8_SCHED
}
}

using pg8::bf16_t; using pg8::f32x4; using pg8::u32x4; using pg8::u32x2; using pg8::bf16x8;
using pg8::gelu_tanh; using pg8::DM; using pg8::MROWS; using pg8::NPROMPT; using pg8::DIN; using pg8::DFF; using pg8::DUP; using pg8::DA; using pg8::EPS;
#define LAS __attribute__((address_space(3)))
typedef float f32x16 __attribute__((ext_vector_type(16)));
typedef short s16x4 __attribute__((ext_vector_type(4)));
constexpr int NTHREADS = 512, NWAVES = 8;
constexpr int LDS_BYTES = 131072 + 2048 + 8 * 192 * 4;
constexpr int NBLK64 = MROWS / 64;

constexpr size_t MiB = 1u << 20;
constexpr size_t WS_SS = 0;
constexpr size_t WS_WSB = 1 * MiB;
constexpr size_t WS_RAB = 1536 * 1024;
constexpr size_t WS_WIN = 2 * MiB;
constexpr size_t WS_WOUT = WS_WIN + 2 * 20 * MiB;
constexpr size_t WS_WUP = WS_WOUT + 2 * 8 * MiB;
constexpr size_t WS_WDN = WS_WUP + 2 * 44 * MiB;
constexpr size_t WS_XB = WS_WDN + 2 * 22 * MiB;
constexpr size_t WS_SB = WS_XB + 130 * MiB;
constexpr size_t WS_PROJ = WS_SB + 90 * MiB;
constexpr size_t WS_MIX = WS_PROJ + 325 * MiB;
constexpr size_t WS_ACT = WS_PROJ;
constexpr size_t WS_PART = WS_MIX + 130 * MiB;
constexpr size_t WS_END = WS_PART + 44 * MiB;
static_assert((size_t)MROWS * DIN * 2 <= 325 * MiB && (size_t)MROWS * DM * 2 <= 130 * MiB && (size_t)MROWS * DFF * 2 <= 455 * MiB && (size_t)NBLK64 * 4 * DUP * 4 <= 90 * MiB, "ws map");
static_assert(WS_END <= (size_t)1024 * MiB, "ws map fits 1 GiB");
constexpr size_t O_Y = 0, O_PS = (size_t)MROWS * DM, O_PF = O_PS + 2 * 2 * 2 * 1024, O_SV = O_PF + 2 * 2 * 2 * DUP, O_SS = O_SV + 2 * 8 * 64 * 1024, O_SF = O_SS + 2 * 8 * 2 * 1024, O_END = O_SF + 2 * 8 * 2 * DUP;

struct Params { const float* in[18]; float* out; unsigned char* ws; int ph_lo, ph_hi; };
typedef const Params __attribute__((address_space(4)))* CParams;
__device__ __forceinline__ CParams params() { CParams p = (CParams)__builtin_amdgcn_kernarg_segment_ptr(); asm volatile("" : "+s"(p)); return p; }

__device__ __forceinline__ float wave_sum(float v) {
#pragma unroll
    for (int o = 1; o < 64; o <<= 1) v += __shfl_xor(v, o);
    return v;
}
__device__ __forceinline__ unsigned f2bf(float f) { unsigned u = __builtin_bit_cast(unsigned, f); return (u + 0x7fffu + ((u >> 16) & 1u)) >> 16; }
__device__ __forceinline__ unsigned pk2(float lo, float hi) { return f2bf(lo) | (f2bf(hi) << 16); }

__device__ __forceinline__ void transpose_item(const float* W, int K, int N, bf16_t* WT, const float* gk, int interleave, LAS float* scr, int item, int lane) {
    const int nblk = N / 32, kb = item / nblk, nb = item % nblk, k0 = 64 * kb, n0 = 32 * nb;
    const float* src = W + (size_t)(k0 + (lane >> 5)) * N + n0 + (lane & 31);
    float w[32];
#pragma unroll
    for (int i = 0; i < 32; ++i) w[i] = src[(size_t)(2 * i) * N];
    const int c = lane & 7;
    f32x4 ga = {1.f, 1.f, 1.f, 1.f}, gb = ga;
    if (gk) { ga = *(const f32x4*)(gk + k0 + 8 * c); gb = *(const f32x4*)(gk + k0 + 8 * c + 4); }
#pragma unroll
    for (int i = 0; i < 32; ++i) scr[(2 * i + (lane >> 5)) * 33 + (lane & 31)] = w[i];
    asm volatile("s_waitcnt lgkmcnt(0)" ::: "memory");
    int drow0 = n0;
    if (interleave == 1) drow0 = n0 < DFF ? (n0 / 128) * 256 + (n0 % 128) : ((n0 - DFF) / 128) * 256 + 128 + ((n0 - DFF) % 128);
    if (interleave == 2 && n0 >= 3072) { const int n1 = n0 - 3072; drow0 = 3072 + (n1 < 1024 ? (n1 / 128) * 256 + (n1 % 128) : ((n1 - 1024) / 128) * 256 + 128 + ((n1 - 1024) % 128)); }
#pragma unroll
    for (int j = 0; j < 4; ++j) { const int n = (lane >> 3) + 8 * j; const LAS float* s = scr + (8 * c) * 33 + n;
        u32x4 o; o.x = pk2(s[0 * 33] * ga[0], s[1 * 33] * ga[1]); o.y = pk2(s[2 * 33] * ga[2], s[3 * 33] * ga[3]); o.z = pk2(s[4 * 33] * gb[0], s[5 * 33] * gb[1]); o.w = pk2(s[6 * 33] * gb[2], s[7 * 33] * gb[3]);
        *(u32x4*)(WT + (size_t)(drow0 + n) * K + k0 + 8 * c) = o; }
    asm volatile("s_waitcnt lgkmcnt(0)" ::: "memory");
}

constexpr int I_IN = (DM / 64) * (DIN / 32), I_OUT = (DM / 64) * (DM / 32), I_UP = (DM / 64) * (DUP / 32), I_DN = (DFF / 64) * (DM / 32), I_L = I_IN + I_OUT + I_UP + I_DN;
__device__ __forceinline__ void convert_weights(LAS unsigned char* lds, CParams P, int l, int r0, int r1, int worker, int nworkers) {
    int tid_ = threadIdx.x; asm volatile("" : "+v"(tid_));
    const int tid = tid_, lane = tid & 63, wave = tid >> 6;
    unsigned char* ws = P->ws;
    LAS float* scr = (LAS float*)(lds + wave * 16384);
    for (int it = r0 + worker * NWAVES + wave; it < r1; it += nworkers * NWAVES) {
        int r = it;
        if (r < I_IN) { transpose_item(P->in[5] + (size_t)l * DM * DIN, DM, DIN, (bf16_t*)(ws + WS_WIN + l * 20 * MiB), P->in[4] + l * DM, 2, scr, r, lane); continue; } r -= I_IN;
        if (r < I_OUT) { const int k0 = 64 * (r / (DM / 32)); const float* g = k0 < DA ? P->in[10] + l * DA : P->in[11] + l * DA - DA;
            transpose_item(P->in[12] + (size_t)l * DM * DM, DM, DM, (bf16_t*)(ws + WS_WOUT + l * 8 * MiB), g, 0, scr, r, lane); continue; } r -= I_OUT;
        if (r < I_UP) { transpose_item(P->in[14] + (size_t)l * DM * DUP, DM, DUP, (bf16_t*)(ws + WS_WUP + l * 44 * MiB), P->in[13] + l * DM, 1, scr, r, lane); continue; } r -= I_UP;
        transpose_item(P->in[16] + (size_t)l * DFF * DM, DFF, DM, (bf16_t*)(ws + WS_WDN + l * 22 * MiB), nullptr, 0, scr, r, lane);
    }
}

__device__ __forceinline__ void prologue_phase(LAS unsigned char* lds, CParams P) {
    int tid_ = threadIdx.x; asm volatile("" : "+v"(tid_));
    const int tid = tid_, lane = tid & 63, wave = tid >> 6;
    const int gw = blockIdx.x * NWAVES + wave, NGW = gridDim.x * NWAVES;
    unsigned char* ws = P->ws;
    LAS float* scr = (LAS float*)(lds + wave * 16384);
    if (gridDim.x == 256) convert_weights(lds, P, 0, 0, I_IN, blockIdx.x, gridDim.x);
    else { convert_weights(lds, P, 0, 0, I_L, blockIdx.x, gridDim.x); convert_weights(lds, P, 1, 0, I_L, blockIdx.x, gridDim.x); }
    float* ss = (float*)(ws + WS_SS); bf16_t* xb = (bf16_t*)(ws + WS_XB);
    for (int m = gw; m < MROWS; m += NGW) {
        const float* xr = m < NPROMPT ? P->in[0] + (size_t)m * DM : P->in[1] + (size_t)(m - NPROMPT) * DM;
        f32x4 v[8]; float s = 0.f;
#pragma unroll
        for (int j = 0; j < 8; ++j) { v[j] = ((const f32x4*)xr)[2 * (lane + 64 * (j >> 1)) + (j & 1)]; s += (v[j][0] * v[j][0] + v[j][1] * v[j][1]) + (v[j][2] * v[j][2] + v[j][3] * v[j][3]); }
        s = wave_sum(s); if (lane == 0) ss[m] = s;
#pragma unroll
        for (int c = 0; c < 4; ++c) { u32x4 w; w.x = pk2(v[2 * c][0], v[2 * c][1]); w.y = pk2(v[2 * c][2], v[2 * c][3]); w.z = pk2(v[2 * c + 1][0], v[2 * c + 1][1]); w.w = pk2(v[2 * c + 1][2], v[2 * c + 1][3]);
            ((u32x4*)(xb + (size_t)m * DM))[lane + 64 * c] = w; }
    }
    const int gt = blockIdx.x * NTHREADS + tid, NGT = gridDim.x * NTHREADS;
    for (int i = gt; i < 4 * MROWS; i += NGT) ss[MROWS + i] = 0.f;
    bf16_t* wsb = (bf16_t*)(ws + WS_WSB);
    for (int i = gt; i < 2 * 8 * 128 * 128 / 2; i += NGT) { const float2 w = ((const float2*)P->in[7])[i]; ((unsigned*)wsb)[i] = pk2(w.x, w.y); }
}

__device__ __forceinline__ unsigned off_b(unsigned row, unsigned ch) { return 256u * row + 16u * (ch ^ (((row & 3) << 2) | ((row >> 2) & 3))); }
__device__ __forceinline__ unsigned tr_read_addr(unsigned lane, unsigned c, unsigned ks, unsigned t) {
    const unsigned h = lane >> 5, blk = (lane >> 4) & 1, q = (lane & 15) >> 2, p = lane & 3;
    return off_b(16 * ks + 8 * h + 4 * t + q, 4 * c + 2 * blk + (p >> 1)) + 8 * (p & 1);
}
__device__ __forceinline__ void mixer_phase(LAS unsigned char* lds, CParams P, int l) {
    int tid_ = threadIdx.x; asm volatile("" : "+v"(tid_));
    const int tid = tid_, lane = tid & 63, wave = __builtin_amdgcn_readfirstlane(tid >> 6);
    unsigned char* ws = P->ws;
    const bf16_t* proj = (const bf16_t*)(ws + WS_PROJ); bf16_t* mix = (bf16_t*)(ws + WS_MIX);
    const bf16_t* wsb = (const bf16_t*)(ws + WS_WSB) + (size_t)l * 8 * 128 * 128;
    const float* vg = P->in[6] + l * DA; const float* bs = P->in[8] + l * 8 * 128; const float* scw = P->in[9] + l * 3 * 1024; const float* st_s = P->in[2] + (size_t)l * 8 * 2 * 1024;
    float* oSV = P->out + O_SV + (size_t)l * 8 * 64 * 1024; float* oPS = P->out + O_PS + (size_t)l * 2 * 2 * 1024; float* oSS = P->out + O_SS + (size_t)l * 8 * 2 * 1024;
    LAS float* SSA = (LAS float*)(lds + 65536);
    LAS float* SSB = (LAS float*)(lds + 65536 + 2048);
    LAS float* RA = (LAS float*)(lds + 65536 + 3072);
    LAS float* RB = (LAS float*)(lds + 65536 + 3584);
    const unsigned ldsbase = (unsigned)(size_t)lds;
    const int tb = wave & 3, dh = wave >> 2;
    for (int cu = blockIdx.x; cu < MROWS / 128; cu += gridDim.x) {
        const int row0 = cu * 128; const bool sample = row0 >= NPROMPT;
        float ssA = 0.f;
        const int wt0 = sample ? 32 * (tb & 1) : 32 * tb;
        const int ks_lo = (sample && tb >= 2) ? 4 : 0, ks_hi = (tb >= 2) ? 8 : 4, wcs = (sample && tb >= 2) ? -64 : 0;
        const int t_abs = row0 + 32 * tb + (lane & 31);
        const int tpos = sample ? ((32 * tb + (lane & 31)) & 63) : (32 * tb + (lane & 31));
        const int ch = tid & 15;
        u32x4 raw[4]; f32x4 vga, vgb;
#pragma unroll
        for (int i = 0; i < 4; ++i) raw[i] = *(const u32x4*)(proj + pg8::proj_off(row0 + (tid >> 4) + 32 * i, 1024 + 8 * ch));
        vga = *(const f32x4*)(vg + 8 * ch); vgb = *(const f32x4*)(vg + 8 * ch + 4);
        for (int h = 0; h < 8; ++h) {
            LAS unsigned char* img = lds + (h & 1) * 32768; const unsigned imgbase = ldsbase + (h & 1) * 32768;
            bf16x8 wf[8];
            const bf16_t* wrow = wsb + ((size_t)(h * 128 + wt0 + (lane & 31))) * 128 + wcs + 8 * (lane >> 5);
#pragma unroll
            for (int ks = 0; ks < 8; ++ks) if (ks >= ks_lo && ks < ks_hi) wf[ks] = *(const bf16x8*)(wrow + 16 * ks);
            u32x2 ur[2][4];
#pragma unroll
            for (int nb = 0; nb < 2; ++nb)
#pragma unroll
                for (int rq = 0; rq < 4; ++rq) ur[nb][rq] = *(const u32x2*)(proj + pg8::proj_off(t_abs, 128 * h + 32 * (2 * dh + nb) + 8 * rq + 4 * (lane >> 5)));
            const float bias = bs[h * 128 + tpos];
            const int hn = h < 7 ? h + 1 : 7;
            u32x4 rawn[4]; f32x4 vgan, vgbn;
#pragma unroll
            for (int i = 0; i < 4; ++i) rawn[i] = *(const u32x4*)(proj + pg8::proj_off(row0 + (tid >> 4) + 32 * i, 1024 + 128 * hn + 8 * ch));
            vgan = *(const f32x4*)(vg + 128 * hn + 8 * ch); vgbn = *(const f32x4*)(vg + 128 * hn + 8 * ch + 4);
#pragma unroll
            for (int i = 0; i < 4; ++i) { const int row = (tid >> 4) + 32 * i; const u32x4 rw = raw[i];
                float g[8]; g[0] = gelu_tanh(pg8::bf_lo(rw.x)); g[1] = gelu_tanh(pg8::bf_hi(rw.x)); g[2] = gelu_tanh(pg8::bf_lo(rw.y)); g[3] = gelu_tanh(pg8::bf_hi(rw.y));
                g[4] = gelu_tanh(pg8::bf_lo(rw.z)); g[5] = gelu_tanh(pg8::bf_hi(rw.z)); g[6] = gelu_tanh(pg8::bf_lo(rw.w)); g[7] = gelu_tanh(pg8::bf_hi(rw.w));
                float s = 0.f;
#pragma unroll
                for (int j = 0; j < 8; ++j) s += g[j] * g[j];
                s += __shfl_xor(s, 1); s += __shfl_xor(s, 2); s += __shfl_xor(s, 4); s += __shfl_xor(s, 8);
                const float rn = pg8::rs_of(s, 1.0f / 128.0f);
                f32x4 o0, o1;
#pragma unroll
                for (int j = 0; j < 4; ++j) { o0[j] = g[j] * rn * vga[j]; o1[j] = g[4 + j] * rn * vgb[j]; }
                if (sample) { float* d = oSV + (size_t)(row0 + row - NPROMPT) * 1024 + 128 * h + 8 * ch; *(f32x4*)d = o0; *(f32x4*)(d + 4) = o1; }
                u32x4 w; w.x = pg8::cvt_pk_bf16(o0[0], o0[1]); w.y = pg8::cvt_pk_bf16(o0[2], o0[3]); w.z = pg8::cvt_pk_bf16(o1[0], o1[1]); w.w = pg8::cvt_pk_bf16(o1[2], o1[3]);
                *(LAS u32x4*)(img + off_b(row, ch)) = w; }
            __syncthreads();
            f32x16 acc[2];
#pragma unroll
            for (int nb = 0; nb < 2; ++nb)
#pragma unroll
                for (int r = 0; r < 16; ++r) acc[nb][r] = 0.f;
            const unsigned a00 = imgbase + tr_read_addr(lane, 2 * dh, 0, 0), a01 = imgbase + tr_read_addr(lane, 2 * dh, 0, 1);
            const unsigned a10 = imgbase + tr_read_addr(lane, 2 * dh + 1, 0, 0), a11 = imgbase + tr_read_addr(lane, 2 * dh + 1, 0, 1);
#pragma unroll
            for (int ks = 0; ks < 8; ++ks) if (ks >= ks_lo && ks < ks_hi) {
                s16x4 f00, f01, f10, f11; const unsigned ko = 4096u * ks;
                asm volatile("ds_read_b64_tr_b16 %0, %4\n\tds_read_b64_tr_b16 %1, %5\n\tds_read_b64_tr_b16 %2, %6\n\tds_read_b64_tr_b16 %3, %7\n\ts_waitcnt lgkmcnt(0)"
                             : "=&v"(f00), "=&v"(f01), "=&v"(f10), "=&v"(f11) : "v"(a00 + ko), "v"(a01 + ko), "v"(a10 + ko), "v"(a11 + ko) : "memory");
                const bf16x8 fa = __builtin_shufflevector(f00, f01, 0, 1, 2, 3, 4, 5, 6, 7), fb = __builtin_shufflevector(f10, f11, 0, 1, 2, 3, 4, 5, 6, 7);
                acc[0] = __builtin_amdgcn_mfma_f32_32x32x16_bf16(fa, wf[ks], acc[0], 0, 0, 0);
                acc[1] = __builtin_amdgcn_mfma_f32_32x32x16_bf16(fb, wf[ks], acc[1], 0, 0, 0);
            }
#pragma unroll
            for (int nb = 0; nb < 2; ++nb)
#pragma unroll
                for (int rq = 0; rq < 4; ++rq) { const int d0 = 32 * (2 * dh + nb) + 8 * rq + 4 * (lane >> 5);
                    const u32x2 rw = ur[nb][rq];
                    const float a0 = gelu_tanh(pg8::bf_lo(rw.x)) * (acc[nb][4 * rq + 0] + bias), a1 = gelu_tanh(pg8::bf_hi(rw.x)) * (acc[nb][4 * rq + 1] + bias);
                    const float a2 = gelu_tanh(pg8::bf_lo(rw.y)) * (acc[nb][4 * rq + 2] + bias), a3 = gelu_tanh(pg8::bf_hi(rw.y)) * (acc[nb][4 * rq + 3] + bias);
                    ssA += (a0 * a0 + a1 * a1) + (a2 * a2 + a3 * a3);
                    u32x2 w; w.x = pg8::cvt_pk_bf16(a0, a1); w.y = pg8::cvt_pk_bf16(a2, a3); *(u32x2*)(mix + (size_t)t_abs * DM + 128 * h + d0) = w; }
#pragma unroll
            for (int i = 0; i < 4; ++i) raw[i] = rawn[i];
            vga = vgan; vgb = vgbn;
        }
        SSA[(dh * 2 + (lane >> 5)) * 128 + 32 * tb + (lane & 31)] = ssA;
        {
            const int cgp = tid & 127, strip = tid >> 7, c0 = 8 * cgp, r0 = row0 + 32 * strip;
            float w0[8], w1[8], w2[8], q1[8], q2[8];
#pragma unroll
            for (int j = 0; j < 8; ++j) { w0[j] = scw[c0 + j]; w1[j] = scw[1024 + c0 + j]; w2[j] = scw[2048 + c0 + j]; }
            const bool seqstart = sample ? ((strip & 1) == 0) : (strip == 0 && (cu & 127) == 0);
            const int sb_ = sample ? (r0 - NPROMPT) / 64 : 0;
            if (seqstart) {
                if (sample) {
#pragma unroll
                    for (int j = 0; j < 8; ++j) { q2[j] = st_s[(sb_ * 2 + 0) * 1024 + c0 + j]; q1[j] = st_s[(sb_ * 2 + 1) * 1024 + c0 + j]; }
                } else {
#pragma unroll
                    for (int j = 0; j < 8; ++j) { q2[j] = 0.f; q1[j] = 0.f; }
                }
            } else {
                const u32x4 c2 = *(const u32x4*)(proj + pg8::proj_off(r0 - 2, 3072 + c0)), c1 = *(const u32x4*)(proj + pg8::proj_off(r0 - 1, 3072 + c0)); const u32x4 h2 = {0x3f803f80u, 0x3f803f80u, 0x3f803f80u, 0x3f803f80u}, h1 = h2;
                q2[0] = pg8::bf_lo(c2.x) * pg8::bf_lo(h2.x); q2[1] = pg8::bf_hi(c2.x) * pg8::bf_hi(h2.x); q2[2] = pg8::bf_lo(c2.y) * pg8::bf_lo(h2.y); q2[3] = pg8::bf_hi(c2.y) * pg8::bf_hi(h2.y);
                q2[4] = pg8::bf_lo(c2.z) * pg8::bf_lo(h2.z); q2[5] = pg8::bf_hi(c2.z) * pg8::bf_hi(h2.z); q2[6] = pg8::bf_lo(c2.w) * pg8::bf_lo(h2.w); q2[7] = pg8::bf_hi(c2.w) * pg8::bf_hi(h2.w);
                q1[0] = pg8::bf_lo(c1.x) * pg8::bf_lo(h1.x); q1[1] = pg8::bf_hi(c1.x) * pg8::bf_hi(h1.x); q1[2] = pg8::bf_lo(c1.y) * pg8::bf_lo(h1.y); q1[3] = pg8::bf_hi(c1.y) * pg8::bf_hi(h1.y);
                q1[4] = pg8::bf_lo(c1.z) * pg8::bf_lo(h1.z); q1[5] = pg8::bf_hi(c1.z) * pg8::bf_hi(h1.z); q1[6] = pg8::bf_lo(c1.w) * pg8::bf_lo(h1.w); q1[7] = pg8::bf_hi(c1.w) * pg8::bf_hi(h1.w);
            }
            const bool st_out = sample ? ((strip & 1) == 1) : (strip == 3 && (cu & 127) == 127);
            float* st_dst = sample ? oSS + (size_t)sb_ * 2 * 1024 + c0 : oPS + (size_t)(cu >> 7) * 2 * 1024 + c0;
#pragma unroll 4
            for (int i = 0; i < 32; ++i) {
                const bf16_t* pr = proj + pg8::proj_off(r0 + i, 2048 + c0);
                const u32x4 gb = *(const u32x4*)pr, gc = *(const u32x4*)(pr + 8 * 16384);     const u32x4 hi = {0x3f803f80u, 0x3f803f80u, 0x3f803f80u, 0x3f803f80u};
                float q[8], b[8], g[8];
                q[0] = pg8::bf_lo(gc.x) * pg8::bf_lo(hi.x); q[1] = pg8::bf_hi(gc.x) * pg8::bf_hi(hi.x); q[2] = pg8::bf_lo(gc.y) * pg8::bf_lo(hi.y); q[3] = pg8::bf_hi(gc.y) * pg8::bf_hi(hi.y);
                q[4] = pg8::bf_lo(gc.z) * pg8::bf_lo(hi.z); q[5] = pg8::bf_hi(gc.z) * pg8::bf_hi(hi.z); q[6] = pg8::bf_lo(gc.w) * pg8::bf_lo(hi.w); q[7] = pg8::bf_hi(gc.w) * pg8::bf_hi(hi.w);
                g[0] = pg8::bf_lo(gb.x); g[1] = pg8::bf_hi(gb.x); g[2] = pg8::bf_lo(gb.y); g[3] = pg8::bf_hi(gb.y); g[4] = pg8::bf_lo(gb.z); g[5] = pg8::bf_hi(gb.z); g[6] = pg8::bf_lo(gb.w); g[7] = pg8::bf_hi(gb.w);
                float s = 0.f;
#pragma unroll
                for (int j = 0; j < 8; ++j) { b[j] = g[j] * (w0[j] * q2[j] + w1[j] * q1[j] + w2[j] * q[j]); s += b[j] * b[j]; }
                u32x4 w; w.x = pg8::cvt_pk_bf16(b[0], b[1]); w.y = pg8::cvt_pk_bf16(b[2], b[3]); w.z = pg8::cvt_pk_bf16(b[4], b[5]); w.w = pg8::cvt_pk_bf16(b[6], b[7]);
                *(u32x4*)(mix + (size_t)(r0 + i) * DM + 1024 + c0) = w;
                if (st_out && i >= 30) { float* d = st_dst + (i - 30) * 1024; *(f32x4*)d = (f32x4){q[0], q[1], q[2], q[3]}; *(f32x4*)(d + 4) = (f32x4){q[4], q[5], q[6], q[7]}; }
                s = wave_sum(s);
                if (lane == 0) SSB[((tid >> 6) & 1) * 128 + 32 * strip + i] = s;
#pragma unroll
                for (int j = 0; j < 8; ++j) { q2[j] = q1[j]; q1[j] = q[j]; }
            }
        }
        __syncthreads();
        if (tid < 128) { const float ra = pg8::rs_of(SSA[tid] + SSA[128 + tid] + SSA[256 + tid] + SSA[384 + tid], 1.0f / 1024.0f), rb = pg8::rs_of(SSB[tid] + SSB[128 + tid], 1.0f / 1024.0f);
            float2* rab = (float2*)(ws + WS_RAB); rab[row0 + tid] = make_float2(ra / rb, rb); }
        __syncthreads();
    }
}

__device__ __forceinline__ void fixup_phase(CParams P, int l) {
    unsigned char* ws = P->ws; const float* sb = (const float*)(ws + WS_SB); bf16_t* act = (bf16_t*)(ws + WS_ACT);
    const float* cw = P->in[15] + (size_t)l * 3 * DUP; const float* st_f = P->in[3] + (size_t)l * 8 * 2 * DUP;
    int tid_ = threadIdx.x; asm volatile("" : "+v"(tid_));
    const int gt = blockIdx.x * NTHREADS + tid_, NGT = gridDim.x * NTHREADS;
    constexpr int NQ = DFF / 4;
    for (int it = gt; it < NBLK64 * 2 * NQ; it += NGT) {
        const int cq = it % NQ, bj = it / NQ, j = bj & 1, blk = bj >> 1, c = 4 * cq;
        const f32x4 z = {0.f, 0.f, 0.f, 0.f};
        f32x4 xg[4], xv[4];
        const float* s0 = sb + (size_t)blk * 4 * DUP + c;
        xg[2] = *(const f32x4*)s0; xv[2] = *(const f32x4*)(s0 + DFF); xg[3] = *(const f32x4*)(s0 + DUP); xv[3] = *(const f32x4*)(s0 + DUP + DFF);
        if (blk >= 512) { const float* sp = st_f + (size_t)(blk - 512) * 2 * DUP + c; xg[0] = *(const f32x4*)sp; xv[0] = *(const f32x4*)(sp + DFF); xg[1] = *(const f32x4*)(sp + DUP); xv[1] = *(const f32x4*)(sp + DUP + DFF); }
        else if ((blk & 255) == 0) { xg[0] = z; xv[0] = z; xg[1] = z; xv[1] = z; }
        else { const float* sp = s0 - 2 * DUP; xg[0] = *(const f32x4*)sp; xv[0] = *(const f32x4*)(sp + DFF); xg[1] = *(const f32x4*)(sp + DUP); xv[1] = *(const f32x4*)(sp + DUP + DFF); }
        const f32x4 wg0 = *(const f32x4*)(cw + c), wg1 = *(const f32x4*)(cw + DUP + c), wg2 = *(const f32x4*)(cw + 2 * DUP + c);
        const f32x4 wv0 = *(const f32x4*)(cw + DFF + c), wv1 = *(const f32x4*)(cw + DUP + DFF + c), wv2 = *(const f32x4*)(cw + 2 * DUP + DFF + c);
        const f32x4 tg0 = j ? xg[1] : xg[0], tg1 = j ? xg[2] : xg[1], tg2 = j ? xg[3] : xg[2], tv0 = j ? xv[1] : xv[0], tv1 = j ? xv[2] : xv[1], tv2 = j ? xv[3] : xv[2];
        const f32x4 G = wg0 * tg0 + wg1 * tg1 + wg2 * tg2, V = wv0 * tv0 + wv1 * tv1 + wv2 * tv2;
        f32x4 a;
#pragma unroll
        for (int e = 0; e < 4; ++e) a[e] = G[e] * V[e] * pg8::sigmoidf_fast(G[e]);
        u32x2 w; w.x = pg8::cvt_pk_bf16(a[0], a[1]); w.y = pg8::cvt_pk_bf16(a[2], a[3]);
        *(u32x2*)(act + (size_t)(blk * 64 + j) * DFF + c) = w;
    }
    float* oPF = P->out + O_PF + (size_t)l * 2 * 2 * DUP; float* oSF = P->out + O_SF + (size_t)l * 8 * 2 * DUP;
    constexpr int NQ2 = DUP / 4;
    for (int it = gt; it < 10 * 2 * NQ2; it += NGT) { const int cq = it % NQ2, sj = it / NQ2, j = sj & 1, s = sj >> 1;
        const int blk = s < 2 ? 256 * s + 255 : 512 + (s - 2);
        const f32x4 v = *(const f32x4*)(sb + ((size_t)blk * 4 + 2 + j) * DUP + 4 * cq);
        float* d = s < 2 ? oPF + ((size_t)s * 2 + j) * DUP : oSF + ((size_t)(s - 2) * 2 + j) * DUP;
        *(f32x4*)(d + 4 * cq) = v; }
}

__device__ __forceinline__ void finalize_phase(CParams P, int ssidx, int nsplit, bool base_in, bool last) {
    int tid_ = threadIdx.x; asm volatile("" : "+v"(tid_));
    const int tid = tid_, lane = tid & 63, wave = tid >> 6;
    const int gw = blockIdx.x * NWAVES + wave, NGW = gridDim.x * NWAVES;
    float* ss = (float*)(P->ws + WS_SS) + (size_t)ssidx * MROWS; bf16_t* xb = (bf16_t*)(P->ws + WS_XB); float* out = P->out;
    const float* part = (const float*)(P->ws + WS_PART); const float* base = P->in[1];
    for (int ms = gw; ms < MROWS - NPROMPT; ms += NGW) { const int m = NPROMPT + ms;
        f32x4 v[8]; float s = 0.f;
        if (base_in) {
#pragma unroll
            for (int j = 0; j < 8; ++j) v[j] = ((const f32x4*)(base + (size_t)ms * DM))[lane + 64 * j];
        } else {
#pragma unroll
            for (int j = 0; j < 8; ++j) { const u32x2 h = ((const u32x2*)(xb + (size_t)m * DM))[lane + 64 * j]; v[j] = (f32x4){pg8::bf_lo(h.x), pg8::bf_hi(h.x), pg8::bf_lo(h.y), pg8::bf_hi(h.y)}; }
        }
        for (int sl = 0; sl < nsplit; ++sl) { const u32x2* pr = (const u32x2*)((const bf16_t*)part + ((size_t)sl * (MROWS - NPROMPT) + ms) * DM);
#pragma unroll
            for (int j = 0; j < 8; ++j) { const u32x2 h = pr[lane + 64 * j]; v[j] += (f32x4){pg8::bf_lo(h.x), pg8::bf_hi(h.x), pg8::bf_lo(h.y), pg8::bf_hi(h.y)}; } }
#pragma unroll
        for (int j = 0; j < 8; ++j) { if (last) ((f32x4*)(out + (size_t)m * DM))[lane + 64 * j] = v[j]; s += (v[j][0] * v[j][0] + v[j][1] * v[j][1]) + (v[j][2] * v[j][2] + v[j][3] * v[j][3]); }
        s = wave_sum(s); if (lane == 0) ss[m] = s;
        if (!last) {
#pragma unroll
            for (int j = 0; j < 8; ++j) { u32x2 w; w.x = pk2(v[j][0], v[j][1]); w.y = pk2(v[j][2], v[j][3]); ((u32x2*)(xb + (size_t)m * DM))[lane + 64 * j] = w; } }
    }
}

__device__ __forceinline__ void final_phase(CParams P) {
    int tid_ = threadIdx.x; asm volatile("" : "+v"(tid_));
    const int tid = tid_, lane = tid & 63, wave = tid >> 6;
    const int gw = blockIdx.x * NWAVES + wave, NGW = gridDim.x * NWAVES;
    const float* g = P->in[17]; float* out = P->out; const bf16_t* xb = (const bf16_t*)(P->ws + WS_XB);
    f32x4 gv[8];
#pragma unroll
    for (int j = 0; j < 8; ++j) gv[j] = ((const f32x4*)g)[2 * (lane + 64 * (j >> 1)) + (j & 1)];
    for (int m = gw; m < MROWS; m += NGW) { f32x4* xr = (f32x4*)(out + (size_t)m * DM); f32x4 v[8]; float s = 0.f;
#pragma unroll
        for (int c = 0; c < 4; ++c) { const u32x4 h = ((const u32x4*)(xb + (size_t)m * DM))[lane + 64 * c];
            v[2 * c] = (f32x4){pg8::bf_lo(h.x), pg8::bf_hi(h.x), pg8::bf_lo(h.y), pg8::bf_hi(h.y)}; v[2 * c + 1] = (f32x4){pg8::bf_lo(h.z), pg8::bf_hi(h.z), pg8::bf_lo(h.w), pg8::bf_hi(h.w)}; }
#pragma unroll
        for (int j = 0; j < 8; ++j) s += (v[j][0] * v[j][0] + v[j][1] * v[j][1]) + (v[j][2] * v[j][2] + v[j][3] * v[j][3]);
        const float rs = pg8::rs_of(wave_sum(s), 1.0f / DM);
#pragma unroll
        for (int j = 0; j < 8; ++j) xr[2 * (lane + 64 * (j >> 1)) + (j & 1)] = v[j] * rs * gv[j]; }
}

constexpr size_t WS_BAR = 768 * 1024;
#define RLX_AGENT __ATOMIC_RELAXED, __HIP_MEMORY_SCOPE_AGENT
#define XB_TMO      128
#define XB_XCNT(j)  (256  + 64 * (j))
#define XB_XSUB(j)  (1280 + 64 * (j))
#define XB_XGEN(j)  (2304 + 64 * (j))
#define XB_TOP      3328
#define XB_TOPGEN   3392
#define XCD_BAR_WORDS 3456
#define XB_SPIN_CAP (1u << 18)

__device__ __forceinline__ unsigned xb_ld(unsigned* p)              { return __hip_atomic_load(p, __ATOMIC_RELAXED, __HIP_MEMORY_SCOPE_AGENT); }
__device__ __forceinline__ unsigned xb_add(unsigned* p, unsigned v) { return __hip_atomic_fetch_add(p, v, __ATOMIC_RELAXED, __HIP_MEMORY_SCOPE_AGENT); }
__device__ __forceinline__ unsigned xb_xcc_id() { return (unsigned)__builtin_amdgcn_s_getreg((3 << 11) | 20) & 0xFu; }
#define XB_SPIN(cond, bar) do { unsigned _sp = 0; while (cond) { __builtin_amdgcn_s_sleep(1); \
    if ((++_sp & 255u) == 0u) { if (xb_ld(&(bar)[XB_TMO])) break; if (_sp > XB_SPIN_CAP) { atomicAdd(&(bar)[XB_TMO], 1u); break; } } } } while (0)

struct XcdBarrier {
    unsigned* bar; unsigned x;
    volatile LAS unsigned* st;
};

__device__ __forceinline__ XcdBarrier xcd_barrier_post(unsigned* bar, volatile LAS unsigned* st) {
    XcdBarrier b; b.bar = bar; b.x = xb_xcc_id(); b.st = st;
    if (threadIdx.x == 0) (void)xb_add(&bar[XB_XCNT(b.x)], 1u);
    return b;
}
__device__ __forceinline__ void xcd_barrier_complete(unsigned* bar, unsigned x, unsigned& nloc, unsigned& nx) {
    const unsigned G = gridDim.x * gridDim.y * gridDim.z;
    unsigned sum, cnt, mine, sp = 0u;
    for (;;) {
        sum = 0u; cnt = 0u; mine = 0u;
#pragma unroll
        for (unsigned j = 0; j < 16; ++j) { const unsigned c = xb_ld(&bar[XB_XCNT(j)]); sum += c; cnt += (c > 0u) ? 1u : 0u; mine = (j == x) ? c : mine; }
        if (sum == G) break;
        __builtin_amdgcn_s_sleep(1);
        if ((++sp & 255u) == 0u) { if (xb_ld(&bar[XB_TMO])) break; if (sp > XB_SPIN_CAP) { atomicAdd(&bar[XB_TMO], 1u); break; } }
    }
    nloc = mine > 0u ? mine : 1u; nx = cnt > 0u ? cnt : 1u;
}

__device__ __forceinline__ void xcd_barrier(const XcdBarrier& b) {
    asm volatile("s_waitcnt vmcnt(0)" ::: "memory");
    __syncthreads();
    if (threadIdx.x == 0) {
        unsigned* bar = b.bar;
        __builtin_amdgcn_s_waitcnt(0);
        unsigned nloc = b.st[0], nx = b.st[1];
        if (nloc == 0u) { xcd_barrier_complete(bar, b.x, nloc, nx); b.st[0] = nloc; b.st[1] = nx; }
        const unsigned old = xb_add(&bar[XB_XSUB(b.x)], 1u);
        const unsigned gen = old / nloc;
        if (old + 1u == (gen + 1u) * nloc) {
            __builtin_amdgcn_fence(__ATOMIC_RELEASE, "agent");
            asm volatile("s_waitcnt vmcnt(0)" ::: "memory");
            const unsigned og = xb_add(&bar[XB_TOP], 1u);
            const unsigned tg = og / nx;
            if (og + 1u == (tg + 1u) * nx) xb_add(&bar[XB_TOPGEN], 1u);
            else XB_SPIN(xb_ld(&bar[XB_TOPGEN]) == tg, bar);
            __builtin_amdgcn_fence(__ATOMIC_ACQUIRE, "agent");
            xb_add(&bar[XB_XGEN(b.x)], 1u);
            asm volatile("s_waitcnt vmcnt(0)" ::: "memory");
        } else {
            XB_SPIN(xb_ld(&bar[XB_XGEN(b.x)]) == gen, bar);
            __builtin_amdgcn_fence(__ATOMIC_ACQUIRE, "agent");
            asm volatile("s_waitcnt vmcnt(0)" ::: "memory");
        }
    }
    __syncthreads();
}

constexpr int N_PHASES = 14;
__global__ void __launch_bounds__(NTHREADS, 2) mk_fwd(Params Parg) {
    extern __shared__ __attribute__((aligned(16))) unsigned char lds_raw[];
    LAS unsigned char* lds = (LAS unsigned char*)lds_raw;
    cg::grid_group grid = cg::this_grid();
    { CParams P = params(); if (P->ph_lo > P->ph_hi) grid.sync(); }
    volatile LAS unsigned* bst = (volatile LAS unsigned*)(lds + 131072 + 1024);
    if (threadIdx.x < 2) bst[threadIdx.x] = 0u;
    __syncthreads();
    { CParams P = params(); (void)xcd_barrier_post((unsigned*)(P->ws + WS_BAR), bst); }
#ifdef ONLY
#define IN(k) ((k) == ONLY)
#else
#define IN(k) true
#endif
#ifdef USE_CG_SYNC
#define GRID_BAR() grid.sync()
#else
#define GRID_BAR() do { XcdBarrier b_; b_.bar = (unsigned*)(params()->ws + WS_BAR); b_.x = xb_xcc_id(); b_.st = (volatile LAS unsigned*)(lds + 131072 + 1024); xcd_barrier(b_); } while (0)
#endif
#ifndef REP_P0
#define REP_P0 1
#endif
#ifndef REP_MIX
#define REP_MIX 1
#endif
#ifndef REP_G1
#define REP_G1 1
#endif
#ifndef REP_G3
#define REP_G3 1
#endif
    if (IN(0)) { for (int rep = 0; rep < REP_P0; ++rep) { prologue_phase(lds, params()); __syncthreads(); } }
    GRID_BAR();
#ifdef REP_SYNC
    for (int rep = 0; rep < REP_SYNC; ++rep) GRID_BAR();
#endif
#pragma unroll
    for (int l = 0; l < 2; ++l) {
        if (IN(1)) {
            CParams P = params(); unsigned char* ws = P->ws; float* ss = (float*)(ws + WS_SS);
            pg8::Gemm g{(const bf16_t*)(ws + WS_XB), (const bf16_t*)(ws + WS_WIN + l * 20 * MiB), MROWS, DIN, DM}; pg8::StaticOrder S; S.init(MROWS, DIN, gridDim.x, blockIdx.x);
            pg8::EpiProj E{(bf16_t*)(ws + WS_PROJ), ss + (l == 0 ? 0 : 2 * MROWS)};
            for (int rep = 0; rep < REP_G1; ++rep) pg8::gemm_phase<pg8::EpiProj, pg8::StaticOrder>(lds, g, S, E, nullptr);
            if (l == 0 && gridDim.x == 256 && blockIdx.x >= 40) { __syncthreads(); convert_weights(lds, P, 0, I_IN, I_IN + I_OUT + I_UP, blockIdx.x - 40, 216); }
        }
        GRID_BAR();
        if (IN(2)) { for (int rep = 0; rep < REP_MIX; ++rep) { mixer_phase(lds, params(), l); __syncthreads(); }
            if (gridDim.x == 256 && blockIdx.x >= 4) {
                if (l == 0) { convert_weights(lds, params(), 0, I_IN + I_OUT + I_UP, I_L, blockIdx.x - 4, 252); convert_weights(lds, params(), 1, 0, I_IN + I_OUT, blockIdx.x - 4, 252); }
                else convert_weights(lds, params(), 1, I_IN + I_OUT + I_UP, I_L, blockIdx.x - 4, 252); } }
        GRID_BAR();
        if (IN(3)) {
            CParams P = params(); unsigned char* ws = P->ws; float* ss = (float*)(ws + WS_SS); float* out = P->out;
            pg8::Gemm g{(const bf16_t*)(ws + WS_MIX), (const bf16_t*)(ws + WS_WOUT + l * 8 * MiB), MROWS, DM, DM}; pg8::SplitOrder S; S.init(DM, gridDim.x, blockIdx.x, 8, 4);
            pg8::EpiResid<true> E{nullptr, nullptr, nullptr, (bf16_t*)(ws + WS_XB), ss + (1 + 2 * l) * MROWS, (float*)(ws + WS_PART), (const float*)(ws + WS_RAB), 1};
            pg8::gemm_phase<pg8::EpiResid<true>, pg8::SplitOrder>(lds, g, S, E, nullptr);
        }
        GRID_BAR();
        if (IN(4)) finalize_phase(params(), 1 + 2 * l, 8, false, false);
        GRID_BAR();
        if (IN(5)) {
            CParams P = params(); unsigned char* ws = P->ws; float* ss = (float*)(ws + WS_SS);
            pg8::Gemm g{(const bf16_t*)(ws + WS_XB), (const bf16_t*)(ws + WS_WUP + l * 44 * MiB), MROWS, DUP, DM}; pg8::StaticOrder S; S.init(MROWS, DUP, gridDim.x, blockIdx.x);
            pg8::EpiFfn E{(bf16_t*)(ws + WS_ACT), ss + (1 + 2 * l) * MROWS, P->in[15] + (size_t)l * 3 * DUP, (float*)(ws + WS_SB), (LAS float*)(lds + 131072 + 2048)};
            for (int rep = 0; rep < REP_G3; ++rep) pg8::gemm_phase<pg8::EpiFfn, pg8::StaticOrder>(lds, g, S, E, nullptr);
            if (l == 0 && gridDim.x == 256 && blockIdx.x >= 88) { __syncthreads(); convert_weights(lds, P, 1, I_IN + I_OUT, I_IN + I_OUT + I_UP, blockIdx.x - 88, 168); }
        }
        GRID_BAR();
        if (IN(6)) fixup_phase(params(), l);
        GRID_BAR();
        if (IN(7)) {
            CParams P = params(); unsigned char* ws = P->ws; float* ss = (float*)(ws + WS_SS); float* out = P->out;
            pg8::Gemm g{(const bf16_t*)(ws + WS_ACT), (const bf16_t*)(ws + WS_WDN + l * 22 * MiB), MROWS, DM, DFF}; pg8::SplitOrder S; S.init(DM, gridDim.x, blockIdx.x, 11, 8);
            pg8::EpiResid<false> E{nullptr, nullptr, nullptr, (bf16_t*)(ws + WS_XB), l == 0 ? ss + 2 * MROWS : nullptr, (float*)(ws + WS_PART), nullptr, 1};
            pg8::gemm_phase<pg8::EpiResid<false>, pg8::SplitOrder>(lds, g, S, E, nullptr);
        }
        GRID_BAR();
        if (IN(8)) finalize_phase(params(), 2, 11, false, false);
        GRID_BAR();
    }
    if (IN(9)) final_phase(params());
#undef IN
}

extern "C" void kernel_launch(void* const* d_in, const int* in_sizes, int n_in, void* d_out, int out_size, void* d_ws, size_t ws_size, hipStream_t stream) {
    static int grid = 0;
    if (grid == 0) {
        if (n_in != 18 || (size_t)out_size != O_END || ws_size < WS_END) { fprintf(stderr, "kernel_launch: unexpected shapes: n_in %d out %d ws %zu (need %zu)\n", n_in, out_size, ws_size, (size_t)WS_END); grid = -1; return; }
        int dev = 0, cus = 0, per_cu = 0;
        hipGetDevice(&dev); hipDeviceGetAttribute(&cus, hipDeviceAttributeMultiprocessorCount, dev);
        if (hipFuncSetAttribute((const void*)mk_fwd, hipFuncAttributeMaxDynamicSharedMemorySize, LDS_BYTES) != hipSuccess) { fprintf(stderr, "kernel_launch: hipFuncSetAttribute failed\n"); grid = -1; return; }
        if (hipOccupancyMaxActiveBlocksPerMultiprocessor(&per_cu, (const void*)mk_fwd, NTHREADS, LDS_BYTES) != hipSuccess || per_cu < 1) { fprintf(stderr, "kernel_launch: occupancy query says %d\n", per_cu); per_cu = 1; }
        (void)hipGetLastError();
        grid = cus * 1;
        fprintf(stderr, "kernel_launch: grid %d (cus %d, per_cu %d)\n", grid, cus, per_cu);
    }
    if (grid < 0) return;
    if (hipMemsetAsync((char*)d_ws + WS_BAR, 0, 16384, stream) != hipSuccess) { fprintf(stderr, "kernel_launch: memset failed\n"); return; }
    Params p{};
    for (int i = 0; i < 18; ++i) p.in[i] = (const float*)d_in[i];
    p.out = (float*)d_out; p.ws = (unsigned char*)d_ws;
    p.ph_lo = 0; p.ph_hi = 1;
    void* args[] = {&p};
    hipError_t e = hipLaunchCooperativeKernel((const void*)mk_fwd, dim3(grid), dim3(NTHREADS), args, LDS_BYTES, stream);
    if (e != hipSuccess) fprintf(stderr, "kernel_launch: cooperative launch failed: %s (grid %d)\n", hipGetErrorString(e), grid);
}
```

```cpp
#include <hip/hip_runtime.h>
#include <hip/hip_cooperative_groups.h>
#include <cstdio>
namespace cg = cooperative_groups;
namespace pg8 {
#define PG8_LAS __attribute__((address_space(3)))
typedef unsigned short bf16_t;
typedef short bf16x8 __attribute__((ext_vector_type(8)));
typedef float f32x4 __attribute__((ext_vector_type(4)));
typedef unsigned u32x4 __attribute__((ext_vector_type(4)));
constexpr int BM = 256, BK = 64, HALF = 128, HTB = HALF * BK * 2  , STAGE_BYTES = 8 * HTB, NXCD = 8, WGM = 8;

__host__ __device__ __forceinline__ int lds_byte(int r, int c) { const int st = (r >> 4) * 2 + (c >> 5), rr = r & 15, cc = c & 31, ob = rr * 64 + cc * 2; return st * 1024 + (ob ^ (((ob >> 9) & 1) << 5)); }
__host__ __device__ __forceinline__ void stage_rc(int b, int& R, int& C) { const int st = b / 1024, sb = b % 1024, swz = sb ^ (((sb >> 9) & 1) << 5); R = (st >> 1) * 16 + swz / 64; C = (st & 1) * 32 + (swz % 64) / 2; }
__host__ __device__ __forceinline__ int perm32(int rho) { const int n = rho >> 4, i = rho & 15; return 8 * (i >> 2) + 4 * n + (i & 3); }

struct Unit { int pm, pn, kt0, nkt; };
struct Gemm { const bf16_t* A; const bf16_t* Bt; int M, N, K; };

struct StaticOrder {
    int nM, nN, nwg, G, c;
    __host__ __device__ void init(int M, int N, int G_, int c_) { nM = M / BM; nN = N / BM; nwg = nM * nN; G = G_; c = c_; }
    __host__ __device__ bool next(int i, Unit& u) const {
        const long L = (long)i * G + c; if (L >= nwg) return false;
        int wgid = (int)L; { const int q = nwg / NXCD, r = nwg % NXCD, xcd = wgid % NXCD, off = wgid / NXCD; wgid = (xcd < r ? xcd * (q + 1) : r * (q + 1) + (xcd - r) * q) + off; }
        const int nig = WGM * nN, gid = wgid / nig, fm = gid * WGM, gsz = (nM - fm) < WGM ? (nM - fm) : WGM;
        u.pm = fm + ((wgid % nig) % gsz); u.pn = (wgid % nig) / gsz; u.kt0 = 0; u.nkt = 0; return true;
    }
    __device__ __forceinline__ void a_ready(const Unit&) const {}
    __device__ __forceinline__ void done(const Unit&) const {}
};
__device__ __forceinline__ unsigned cvt_pk_bf16(float lo, float hi) { unsigned r; asm volatile("v_cvt_pk_bf16_f32 %0, %1, %2" : "=v"(r) : "v"(lo), "v"(hi)); return r; }
typedef float f32x2 __attribute__((ext_vector_type(2)));

constexpr int DM = 2048, MROWS = 33280, NPROMPT = 32768, DIN = 5120, DFF = 5632, DUP = 11264, DA = 1024;
constexpr float EPS = 1e-6f;
typedef unsigned u32x2 __attribute__((ext_vector_type(2)));
__device__ __forceinline__ float rs_of(float ss, float invn) { return __builtin_amdgcn_rsqf(ss * invn + EPS); }
__device__ __forceinline__ float bf_lo(unsigned w) { return __uint_as_float(w << 16); }
__device__ __forceinline__ float bf_hi(unsigned w) { return __uint_as_float(w & 0xffff0000u); }
__device__ __forceinline__ float sigmoidf_fast(float x) { return __builtin_amdgcn_rcpf(1.0f + __builtin_amdgcn_exp2f(-1.44269504089f * x)); }
__device__ __forceinline__ float gelu_tanh(float x) { const float u = 1.5957691216f * x * (1.0f + 0.044715f * x * x); return x * sigmoidf_fast(u); }
template <int CTRL> __device__ __forceinline__ float dpp_mov(float src) {
    return __builtin_bit_cast(float, __builtin_amdgcn_mov_dpp(__builtin_bit_cast(int, src), CTRL, 0xf, 0xf, true)); }
template <int CTRL> __device__ __forceinline__ float dpp_f(float old, float src) {
    return __builtin_bit_cast(float, __builtin_amdgcn_update_dpp(__builtin_bit_cast(int, old), __builtin_bit_cast(int, src), CTRL, 0xf, 0xf, false)); }

struct SplitOrder {
    StaticOrder base; int nN, nsplit, nkt_item, nitems, G, c;
    __host__ __device__ void init(int N, int G_, int c_, int nsplit_, int nkt_item_) { base.init(NPROMPT, N, G_, c_); nN = N / BM; nsplit = nsplit_; nkt_item = nkt_item_; nitems = ((MROWS - NPROMPT) / BM) * nN * nsplit; G = G_; c = c_; }
    __host__ __device__ bool next(int i, Unit& u) const {
        const int np = c < base.nwg ? (base.nwg - c + G - 1) / G : 0;
        if (i < np) return base.next(i, u);
        const int j = (i - np) * G + c; if (j >= nitems) return false;
        const int tile = j / nsplit; u.pm = NPROMPT / BM + tile / nN; u.pn = tile % nN; u.kt0 = (j % nsplit) * nkt_item; u.nkt = nkt_item; return true;
    }
    __device__ __forceinline__ void a_ready(const Unit&) const {}
    __device__ __forceinline__ void done(const Unit&) const {}
};
__device__ __forceinline__ size_t proj_off(int r, int c) { return ((size_t)(r >> 7) * 32 + (c >> 7)) * 16384 + (size_t)(r & 127) * 128 + (c & 127); }
struct EpiProj {
    static constexpr bool PERM = true, AFTER_DRAIN = false, MIDK = false;
    bf16_t* O; const float* ss;
    __device__ __forceinline__ void operator()(f32x4 (&acc)[2][2][4][2], const Unit& u, int wr, int wc, int fr, int fq) const {
        const int row0 = u.pm * BM + wr * 64 + fr, col0 = u.pn * BM + wc * 32 + 8 * fq;
        float rsv[2][4];
#pragma unroll
        for (int ai = 0; ai < 2; ++ai)
#pragma unroll
            for (int m = 0; m < 4; ++m) rsv[ai][m] = ss[row0 + ai * HALF + m * 16];
#pragma unroll
        for (int ai = 0; ai < 2; ++ai)
#pragma unroll
            for (int m = 0; m < 4; ++m) { const int r = row0 + ai * HALF + m * 16; const float rs = rs_of(rsv[ai][m], 1.0f / DM);
                if (u.pn >= 12) {
                    const float rq = rs * rs; const f32x4 v0 = acc[ai][0][m][0] * acc[ai][1][m][0] * rq, v1 = acc[ai][0][m][1] * acc[ai][1][m][1] * rq;
                    u32x4 w; w.x = cvt_pk_bf16(v0[0], v0[1]); w.y = cvt_pk_bf16(v0[2], v0[3]); w.z = cvt_pk_bf16(v1[0], v1[1]); w.w = cvt_pk_bf16(v1[2], v1[3]);
                    *(u32x4*)(O + proj_off(r, 3072 + (u.pn - 12) * HALF + wc * 32 + 8 * fq)) = w;
                } else {
                bf16_t* rowp = O + proj_off(r, col0);
#pragma unroll
                for (int bj = 0; bj < 2; ++bj) { const f32x4 v0 = acc[ai][bj][m][0] * rs, v1 = acc[ai][bj][m][1] * rs;
                    u32x4 w; w.x = cvt_pk_bf16(v0[0], v0[1]); w.y = cvt_pk_bf16(v0[2], v0[3]); w.z = cvt_pk_bf16(v1[0], v1[1]); w.w = cvt_pk_bf16(v1[2], v1[3]);
                    *(u32x4*)(rowp + bj * 16384) = w; } } }
    }
};
template <bool SCALE> struct EpiResid {
    static constexpr bool PERM = true, AFTER_DRAIN = false, MIDK = SCALE;
    const float* baseP; const float* baseS; float* out; bf16_t* xb; float* ssout; float* part; const float* rab; int wxb;
    __device__ __forceinline__ void midk(f32x4 (&acc)[2][2][4][2], const Unit& u, int wr, int fr) const {
        float q[2][4];
#pragma unroll
        for (int ai = 0; ai < 2; ++ai)
#pragma unroll
            for (int m = 0; m < 4; ++m) q[ai][m] = rab[2 * (u.pm * BM + wr * 64 + fr + ai * HALF + m * 16)];
#pragma unroll
        for (int ai = 0; ai < 2; ++ai)
#pragma unroll
            for (int m = 0; m < 4; ++m)
#pragma unroll
                for (int bj = 0; bj < 2; ++bj)
#pragma unroll
                    for (int n = 0; n < 2; ++n) acc[ai][bj][m][n] *= q[ai][m];
    }
    __device__ __forceinline__ void operator()(f32x4 (&acc)[2][2][4][2], const Unit& u, int wr, int wc, int fr, int fq) const {
        const int row0 = u.pm * BM + wr * 64 + fr, col0 = u.pn * BM + wc * 32 + 8 * fq;
        if (u.nkt) {
            bf16_t* pp = (bf16_t*)part + ((size_t)(u.kt0 / u.nkt) * (MROWS - NPROMPT) + (row0 - NPROMPT)) * DM + col0;
            float f[2][4];
#pragma unroll
            for (int ai = 0; ai < 2; ++ai)
#pragma unroll
                for (int m = 0; m < 4; ++m) { f[ai][m] = 1.0f;
                    if (SCALE) { const float* rp = rab + 2 * (row0 + ai * HALF + m * 16); const float rb = rp[1]; f[ai][m] = u.kt0 < 16 ? rp[0] * rb : rb; } }
#pragma unroll
            for (int ai = 0; ai < 2; ++ai)
#pragma unroll
                for (int m = 0; m < 4; ++m)
#pragma unroll
                    for (int bj = 0; bj < 2; ++bj) { const f32x4 o0 = acc[ai][bj][m][0] * f[ai][m], o1 = acc[ai][bj][m][1] * f[ai][m];
                        u32x4 w; w.x = cvt_pk_bf16(o0[0], o0[1]); w.y = cvt_pk_bf16(o0[2], o0[3]); w.z = cvt_pk_bf16(o1[0], o1[1]); w.w = cvt_pk_bf16(o1[2], o1[3]);
                        *(u32x4*)(pp + (size_t)(ai * HALF + m * 16) * DM + bj * HALF) = w; }
            return;
        }
        const bf16_t* bb = xb + (size_t)row0 * DM + col0;
        u32x4 hb[2][4][2]; float rbv[2][4];
#pragma unroll
        for (int ai = 0; ai < 2; ++ai)
#pragma unroll
            for (int m = 0; m < 4; ++m) {
#pragma unroll
                for (int bj = 0; bj < 2; ++bj) hb[ai][m][bj] = *(const u32x4*)(bb + (size_t)(ai * HALF + m * 16) * DM + bj * HALF);
                rbv[ai][m] = SCALE ? rab[2 * (row0 + ai * HALF + m * 16) + 1] : 1.0f; }
        asm volatile("" ::: "memory");
#pragma unroll
        for (int ai = 0; ai < 2; ++ai)
#pragma unroll
            for (int m = 0; m < 4; ++m) { const int r = row0 + ai * HALF + m * 16; float s = 0.f;
#pragma unroll
                for (int bj = 0; bj < 2; ++bj) { const u32x4 h = hb[ai][m][bj];
                    const f32x4 b0 = {bf_lo(h.x), bf_hi(h.x), bf_lo(h.y), bf_hi(h.y)}, b1 = {bf_lo(h.z), bf_hi(h.z), bf_lo(h.w), bf_hi(h.w)};
                    const f32x4 o0 = SCALE ? acc[ai][bj][m][0] * rbv[ai][m] + b0 : acc[ai][bj][m][0] + b0, o1 = SCALE ? acc[ai][bj][m][1] * rbv[ai][m] + b1 : acc[ai][bj][m][1] + b1;
                    s += ((o0[0] * o0[0] + o0[1] * o0[1]) + (o0[2] * o0[2] + o0[3] * o0[3])) + ((o1[0] * o1[0] + o1[1] * o1[1]) + (o1[2] * o1[2] + o1[3] * o1[3]));
                    u32x4 w; w.x = cvt_pk_bf16(o0[0], o0[1]); w.y = cvt_pk_bf16(o0[2], o0[3]); w.z = cvt_pk_bf16(o1[0], o1[1]); w.w = cvt_pk_bf16(o1[2], o1[3]);
                    *(u32x4*)(xb + (size_t)r * DM + col0 + bj * HALF) = w; }
                s += __shfl_xor(s, 16); s += __shfl_xor(s, 32);
                if (ssout && fq == 0) unsafeAtomicAdd(ssout + r, s); }
    }
};
struct EpiFfn {
    static constexpr bool PERM = true, AFTER_DRAIN = false, MIDK = false;
    bf16_t* act; const float* ss; const float* cw; float* sb; PG8_LAS float* wl;
    __device__ __forceinline__ void operator()(f32x4 (&acc)[2][2][4][2], const Unit& u, int wr, int wc, int fr, int fq) const {
        const int rt0 = wr * 64 + fr, gc0 = u.pn * 128 + wc * 32 + 8 * fq;
        PG8_LAS float* wimg = wl + (wr * 4 + wc) * 192;
        if (fr < 6) { const float* src = cw + (size_t)(fr % 3) * DUP + (fr / 3) * DFF + gc0; const f32x4 w0 = *(const f32x4*)src, w1 = *(const f32x4*)(src + 4);
            *(PG8_LAS f32x4*)(wimg + fr * 32 + 8 * fq) = w0; *(PG8_LAS f32x4*)(wimg + fr * 32 + 8 * fq + 4) = w1; }
        {
            float rsv[2][4];
#pragma unroll
            for (int ai = 0; ai < 2; ++ai)
#pragma unroll
                for (int m = 0; m < 4; ++m) rsv[ai][m] = ss[u.pm * BM + rt0 + ai * HALF + m * 16];
#pragma unroll
            for (int ai = 0; ai < 2; ++ai)
#pragma unroll
                for (int m = 0; m < 4; ++m) { const float rs = rs_of(rsv[ai][m], 1.0f / DM);
#pragma unroll
                    for (int bj = 0; bj < 2; ++bj)
#pragma unroll
                        for (int n = 0; n < 2; ++n) acc[ai][bj][m][n] *= rs; }
        }
#pragma unroll
        for (int ai = 0; ai < 2; ++ai) { const int blk = u.pm * 4 + ai * 2 + wr;
            u32x2 keep[4];
#pragma unroll
            for (int n = 0; n < 2; ++n) { const int gc = gc0 + 4 * n;
                const PG8_LAS float* wq = wimg + 8 * fq + 4 * n;
                const f32x4 wg0 = *(const PG8_LAS f32x4*)wq, wg1 = *(const PG8_LAS f32x4*)(wq + 32), wg2 = *(const PG8_LAS f32x4*)(wq + 64);
                const f32x4 wv0 = *(const PG8_LAS f32x4*)(wq + 96), wv1 = *(const PG8_LAS f32x4*)(wq + 128), wv2 = *(const PG8_LAS f32x4*)(wq + 160);
#pragma unroll
                for (int m = 0; m < 4; ++m) { const f32x4 pg = acc[ai][0][m][n], pv = acc[ai][1][m][n];
                    const f32x4 pgp = acc[ai][0][m ? m - 1 : 0][n], pvp = acc[ai][1][m ? m - 1 : 0][n];
                    f32x4 a;
#pragma unroll
                    for (int h = 0; h < 2; ++h) {
                        f32x2 s1g, s2g, s1v, s2v;
#pragma unroll
                        for (int k = 0; k < 2; ++k) { const int j = 2 * h + k;
                            if (m) { s1g[k] = dpp_f<0x111>(dpp_mov<0x121>(pgp[j]), pg[j]); s2g[k] = dpp_f<0x112>(dpp_mov<0x122>(pgp[j]), pg[j]);
                                     s1v[k] = dpp_f<0x111>(dpp_mov<0x121>(pvp[j]), pv[j]); s2v[k] = dpp_f<0x112>(dpp_mov<0x122>(pvp[j]), pv[j]); }
                            else   { s1g[k] = dpp_mov<0x111>(pg[j]); s2g[k] = dpp_mov<0x112>(pg[j]); s1v[k] = dpp_mov<0x111>(pv[j]); s2v[k] = dpp_mov<0x112>(pv[j]); } }
                        const f32x2 pg2 = {pg[2 * h], pg[2 * h + 1]}, pv2 = {pv[2 * h], pv[2 * h + 1]};
                        const f32x2 G = (f32x2){wg0[2 * h], wg0[2 * h + 1]} * s2g + (f32x2){wg1[2 * h], wg1[2 * h + 1]} * s1g + (f32x2){wg2[2 * h], wg2[2 * h + 1]} * pg2;
                        const f32x2 V = (f32x2){wv0[2 * h], wv0[2 * h + 1]} * s2v + (f32x2){wv1[2 * h], wv1[2 * h + 1]} * s1v + (f32x2){wv2[2 * h], wv2[2 * h + 1]} * pv2;
                        const f32x2 GV = G * V;
                        a[2 * h] = GV[0] * sigmoidf_fast(G[0]); a[2 * h + 1] = GV[1] * sigmoidf_fast(G[1]);
                    }
                    const int r = u.pm * BM + ai * HALF + rt0 + m * 16;
                    { u32x2 w; w.x = cvt_pk_bf16(a[0], a[1]); w.y = cvt_pk_bf16(a[2], a[3]);
                      if (n == 0) keep[m] = w;
                      else if (!(m == 0 && fr < 2)) { u32x4 w4; w4.x = keep[m].x; w4.y = keep[m].y; w4.z = w.x; w4.w = w.y; *(u32x4*)(act + (size_t)r * DFF + gc0) = w4; } }
                    if (m == 0 && fr < 2) { float* p = sb + ((size_t)blk * 4 + fr) * DUP + gc; *(f32x4*)p = pg; *(f32x4*)(p + DFF) = pv; }
                    if (m == 3 && fr >= 14) { float* p = sb + ((size_t)blk * 4 + fr - 12) * DUP + gc; *(f32x4*)p = pg; *(f32x4*)(p + DFF) = pv; }
                }
            }
        }
    }
};
template <class Epi, class Sched, bool STAMP = false>
__device__ __forceinline__ void gemm_phase(PG8_LAS unsigned char* lds, const Gemm g, const Sched& S, const Epi& E, unsigned long long* stamps) {
    int tid_ = threadIdx.x; asm volatile("" : "+v"(tid_));
    const int tid = tid_, wid = __builtin_amdgcn_readfirstlane(tid >> 6), lane = tid & 63, wr = wid >> 2, wc = wid & 3, fr = lane & 15, fq = lane >> 4;
    const int K = g.K, nt = K / BK;
    int ts_lo = 0, ts_hi = 0, nts = 0; const unsigned long long rt_entry = STAMP ? (unsigned long long)wall_clock64() : 0ull;
#define PG8_STAMP() do { if (STAMP && wid == 0 && nts < 64) { const unsigned long long _c = (unsigned long long)clock64(); \
        ts_lo = (lane == nts) ? (int)(unsigned)_c : ts_lo; ts_hi = (lane == nts) ? (int)(unsigned)(_c >> 32) : ts_hi; ++nts; } } while (0)
    PG8_STAMP();
    unsigned voffA[2], voffB[2];
#pragma unroll
    for (int i = 0; i < 2; ++i) { int R, C; stage_rc(tid * 16 + i * 8192, R, C); const int Rb = Epi::PERM ? ((R & ~31) + perm32(R & 31)) : R;
        voffA[i] = (unsigned)(R * K + C) * 2u; voffB[i] = (unsigned)(Rb * K + C) * 2u; }
    const size_t kstep = (size_t)(BK * 2);
    const size_t hstep = (size_t)HALF * K * 2;
    const size_t tstep = 2 * hstep;
    const unsigned ldsw = (unsigned)wid * 1024u;
    const int aoff = lds_byte(wr * 64 + fr, fq * 8), boff = lds_byte(wc * 32 + fr, fq * 8);
#define PG8_SA(b, h) (((b) * 2 + (h)) * HTB)
#define PG8_SB(b, h) ((4 + (b) * 2 + (h)) * HTB)
#define PG8_STAGE(bufoff, gbase, voff) do { _Pragma("unroll") for (int _i = 0; _i < 2; ++_i) \
        __builtin_amdgcn_global_load_lds((const unsigned*)((const char*)(gbase) + (voff)[_i]), (PG8_LAS unsigned*)(lds + (bufoff) + ldsw + _i * 8192), 16, 0, 0); } while (0)
#define PG8_LDA(dst, b, h) do { _Pragma("unroll") for (int m = 0; m < 4; ++m) _Pragma("unroll") for (int k = 0; k < 2; ++k) dst[m][k] = *(const PG8_LAS bf16x8*)(lds + PG8_SA(b, h) + aoff + m * 2048 + k * 1024); } while (0)
#define PG8_LDB(dst, b, h) do { _Pragma("unroll") for (int n = 0; n < 2; ++n) _Pragma("unroll") for (int k = 0; k < 2; ++k) dst[n][k] = *(const PG8_LAS bf16x8*)(lds + PG8_SB(b, h) + boff + n * 2048 + k * 1024); } while (0)
#define PG8_MMA(ai, bj, At, Bt) do { __builtin_amdgcn_s_setprio(1); _Pragma("unroll") for (int m = 0; m < 4; ++m) _Pragma("unroll") for (int n = 0; n < 2; ++n) _Pragma("unroll") for (int k = 0; k < 2; ++k) \
        acc[ai][bj][m][n] = __builtin_amdgcn_mfma_f32_16x16x32_bf16(Bt[n][k], At[m][k], acc[ai][bj][m][n], 0, 0, 0); __builtin_amdgcn_s_setprio(0); } while (0)
#define PG8_WAIT_V(n) asm volatile("s_waitcnt vmcnt(" #n ")" ::: "memory")
#define PG8_WAIT_L(n) asm volatile("s_waitcnt lgkmcnt(" #n ")" ::: "memory")
#define PG8_BAR __builtin_amdgcn_s_barrier()
#define PG8_SCHED __builtin_amdgcn_sched_barrier(0)
    Unit cur, nxt; int ui = 0;
    if (!S.next(0, cur)) return;
    f32x4 acc[2][2][4][2];
#pragma unroll
    for (int a = 0; a < 2; ++a)
#pragma unroll
        for (int b = 0; b < 2; ++b)
#pragma unroll
            for (int m = 0; m < 4; ++m)
#pragma unroll
                for (int n = 0; n < 2; ++n) acc[a][b][m][n] = (f32x4){0.f, 0.f, 0.f, 0.f};
    bf16x8 At[4][2], B0[2][2], B1[2][2];
    const char* cA = (const char*)g.A + (size_t)cur.pm * tstep + (size_t)cur.kt0 * kstep; const char* cB = (const char*)g.Bt + (size_t)cur.pn * tstep + (size_t)cur.kt0 * kstep;
    S.a_ready(cur);
    PG8_STAGE(PG8_SB(0, 0), cB, voffB); PG8_STAGE(PG8_SA(0, 0), cA, voffA); PG8_STAGE(PG8_SB(0, 1), cB + hstep, voffB); PG8_STAGE(PG8_SA(0, 1), cA + hstep, voffA);
    if (wr == 1) PG8_BAR;
    PG8_WAIT_V(4); PG8_BAR;
    PG8_STAGE(PG8_SB(1, 0), cB + kstep, voffB); PG8_STAGE(PG8_SA(1, 0), cA + kstep, voffA); PG8_STAGE(PG8_SB(1, 1), cB + hstep + kstep, voffB);
    PG8_WAIT_V(6); PG8_BAR;
    PG8_STAMP();
    for (;;) {
        const bool has_next = S.next(ui + 1, nxt);
        const char* nA = has_next ? (const char*)g.A + (size_t)nxt.pm * tstep + (size_t)nxt.kt0 * kstep : cA; const char* nB = has_next ? (const char*)g.Bt + (size_t)nxt.pn * tstep + (size_t)nxt.kt0 * kstep : cB;
        const int unt = cur.nkt ? cur.nkt : nt;
        for (int t = 0; t < unt; t += 2) {
            if constexpr (Epi::MIDK) { if (t == (nt >> 1) && cur.nkt == 0) E.midk(acc, cur, wr, fr); }
            const bool last = (t == unt - 2);
            const char* a1 = cA + (size_t)(t + 1) * kstep;
            const char* a2 = last ? nA : cA + (size_t)(t + 2) * kstep; const char* b2 = last ? nB : cB + (size_t)(t + 2) * kstep;
            const char* a3 = a2 + kstep; const char* b3 = b2 + kstep;
            if (last && has_next) S.a_ready(nxt);
            PG8_LDB(B0, 0, 0); PG8_SCHED; PG8_LDA(At, 0, 0); PG8_STAGE(PG8_SA(1, 1), a1 + hstep, voffA);
            PG8_WAIT_L(8); PG8_BAR; PG8_WAIT_L(0); PG8_MMA(0, 0, At, B0); PG8_BAR; PG8_SCHED;
            PG8_LDB(B1, 0, 1); PG8_STAGE(PG8_SB(0, 0), b2, voffB);
            PG8_BAR; PG8_WAIT_L(0); PG8_MMA(0, 1, At, B1); PG8_BAR;
            PG8_LDA(At, 0, 1); PG8_STAGE(PG8_SA(0, 0), a2, voffA);
            PG8_BAR; PG8_WAIT_L(0); PG8_MMA(1, 0, At, B0); PG8_BAR; PG8_SCHED;
            PG8_STAGE(PG8_SB(0, 1), b2 + hstep, voffB);
            PG8_WAIT_V(6); PG8_BAR; PG8_MMA(1, 1, At, B1); PG8_BAR;
            PG8_LDB(B0, 1, 0); PG8_SCHED; PG8_LDA(At, 1, 0); PG8_STAGE(PG8_SA(0, 1), a2 + hstep, voffA);
            PG8_WAIT_L(8); PG8_BAR; PG8_WAIT_L(0); PG8_MMA(0, 0, At, B0); PG8_BAR; PG8_SCHED;
            PG8_LDB(B1, 1, 1); PG8_STAGE(PG8_SB(1, 0), b3, voffB);
            PG8_BAR; PG8_WAIT_L(0); PG8_MMA(0, 1, At, B1); PG8_BAR;
            PG8_LDA(At, 1, 1); PG8_STAGE(PG8_SA(1, 0), a3, voffA);
            PG8_BAR; PG8_WAIT_L(0); PG8_MMA(1, 0, At, B0); PG8_BAR; PG8_SCHED;
            PG8_STAGE(PG8_SB(1, 1), b3 + hstep, voffB);
            PG8_WAIT_V(6); PG8_BAR; PG8_MMA(1, 1, At, B1); PG8_BAR;
        }
        PG8_STAMP();
        if constexpr (!Epi::AFTER_DRAIN) { E(acc, cur, wr, wc, fr, fq); S.done(cur); }
        PG8_STAMP();
        if (!has_next) break;
#pragma unroll
        for (int a = 0; a < 2; ++a)
#pragma unroll
            for (int b = 0; b < 2; ++b)
#pragma unroll
                for (int m = 0; m < 4; ++m)
#pragma unroll
                    for (int n = 0; n < 2; ++n) acc[a][b][m][n] = (f32x4){0.f, 0.f, 0.f, 0.f};
        cur = nxt; cA = nA; cB = nB; ++ui;
    }
    PG8_WAIT_V(0);
    if (wr == 0) PG8_BAR;
    PG8_BAR;
    if constexpr (Epi::AFTER_DRAIN) { E.fused(acc, cur, wr, wc, fr, fq, lds, wid, lane); S.done(cur); }
    PG8_STAMP();
    if (STAMP && wid == 0) { stamps[lane] = lane < nts ? (((unsigned long long)(unsigned)ts_hi << 32) | (unsigned)ts_lo) : 0ull;
        if (lane == 62) stamps[62] = rt_entry; if (lane == 63) stamps[63] = (unsigned long long)wall_clock64(); }
#undef PG8_STAMP
#undef PG8_SA
#undef PG8_SB
#undef PG8_STAGE
#undef PG8_LDA
#undef PG8_LDB
#undef PG8_MMA
#undef PG8_WAIT_V
#undef PG8_WAIT_L
#undef PG8_BAR
#undef PG8_SCHED
}
}

using pg8::bf16_t; using pg8::f32x4; using pg8::u32x4; using pg8::u32x2; using pg8::bf16x8;
using pg8::gelu_tanh; using pg8::DM; using pg8::MROWS; using pg8::NPROMPT; using pg8::DIN; using pg8::DFF; using pg8::DUP; using pg8::DA; using pg8::EPS;
#define LAS __attribute__((address_space(3)))
typedef float f32x16 __attribute__((ext_vector_type(16)));
typedef short s16x4 __attribute__((ext_vector_type(4)));
constexpr int NTHREADS = 512, NWAVES = 8;
constexpr int LDS_BYTES = 131072 + 2048 + 8 * 192 * 4;
constexpr int NBLK64 = MROWS / 64;

constexpr size_t MiB = 1u << 20;
constexpr size_t WS_SS = 0;
constexpr size_t WS_WSB = 1 * MiB;
constexpr size_t WS_RAB = 1536 * 1024;
constexpr size_t WS_WIN = 2 * MiB;
constexpr size_t WS_WOUT = WS_WIN + 2 * 20 * MiB;
constexpr size_t WS_WUP = WS_WOUT + 2 * 8 * MiB;
constexpr size_t WS_WDN = WS_WUP + 2 * 44 * MiB;
constexpr size_t WS_XB = WS_WDN + 2 * 22 * MiB;
constexpr size_t WS_SB = WS_XB + 130 * MiB;
constexpr size_t WS_PROJ = WS_SB + 90 * MiB;
constexpr size_t WS_MIX = WS_PROJ + 325 * MiB;
constexpr size_t WS_ACT = WS_PROJ;
constexpr size_t WS_PART = WS_MIX + 130 * MiB;
constexpr size_t WS_END = WS_PART + 44 * MiB;
static_assert((size_t)MROWS * DIN * 2 <= 325 * MiB && (size_t)MROWS * DM * 2 <= 130 * MiB && (size_t)MROWS * DFF * 2 <= 455 * MiB && (size_t)NBLK64 * 4 * DUP * 4 <= 90 * MiB, "ws map");
static_assert(WS_END <= (size_t)1024 * MiB, "ws map fits 1 GiB");
constexpr size_t O_Y = 0, O_PS = (size_t)MROWS * DM, O_PF = O_PS + 2 * 2 * 2 * 1024, O_SV = O_PF + 2 * 2 * 2 * DUP, O_SS = O_SV + 2 * 8 * 64 * 1024, O_SF = O_SS + 2 * 8 * 2 * 1024, O_END = O_SF + 2 * 8 * 2 * DUP;

struct Params { const float* in[18]; float* out; unsigned char* ws; int ph_lo, ph_hi; };
typedef const Params __attribute__((address_space(4)))* CParams;
__device__ __forceinline__ CParams params() { CParams p = (CParams)__builtin_amdgcn_kernarg_segment_ptr(); asm volatile("" : "+s"(p)); return p; }

__device__ __forceinline__ float wave_sum(float v) {
#pragma unroll
    for (int o = 1; o < 64; o <<= 1) v += __shfl_xor(v, o);
    return v;
}
__device__ __forceinline__ unsigned f2bf(float f) { unsigned u = __builtin_bit_cast(unsigned, f); return (u + 0x7fffu + ((u >> 16) & 1u)) >> 16; }
__device__ __forceinline__ unsigned pk2(float lo, float hi) { return f2bf(lo) | (f2bf(hi) << 16); }

__device__ __forceinline__ void transpose_item(const float* W, int K, int N, bf16_t* WT, const float* gk, int interleave, LAS float* scr, int item, int lane) {
    const int nblk = N / 32, kb = item / nblk, nb = item % nblk, k0 = 64 * kb, n0 = 32 * nb;
    const float* src = W + (size_t)(k0 + (lane >> 5)) * N + n0 + (lane & 31);
    float w[32];
#pragma unroll
    for (int i = 0; i < 32; ++i) w[i] = src[(size_t)(2 * i) * N];
    const int c = lane & 7;
    f32x4 ga = {1.f, 1.f, 1.f, 1.f}, gb = ga;
    if (gk) { ga = *(const f32x4*)(gk + k0 + 8 * c); gb = *(const f32x4*)(gk + k0 + 8 * c + 4); }
#pragma unroll
    for (int i = 0; i < 32; ++i) scr[(2 * i + (lane >> 5)) * 33 + (lane & 31)] = w[i];
    asm volatile("s_waitcnt lgkmcnt(0)" ::: "memory");
    int drow0 = n0;
    if (interleave == 1) drow0 = n0 < DFF ? (n0 / 128) * 256 + (n0 % 128) : ((n0 - DFF) / 128) * 256 + 128 + ((n0 - DFF) % 128);
    if (interleave == 2 && n0 >= 3072) { const int n1 = n0 - 3072; drow0 = 3072 + (n1 < 1024 ? (n1 / 128) * 256 + (n1 % 128) : ((n1 - 1024) / 128) * 256 + 128 + ((n1 - 1024) % 128)); }
#pragma unroll
    for (int j = 0; j < 4; ++j) { const int n = (lane >> 3) + 8 * j; const LAS float* s = scr + (8 * c) * 33 + n;
        u32x4 o; o.x = pk2(s[0 * 33] * ga[0], s[1 * 33] * ga[1]); o.y = pk2(s[2 * 33] * ga[2], s[3 * 33] * ga[3]); o.z = pk2(s[4 * 33] * gb[0], s[5 * 33] * gb[1]); o.w = pk2(s[6 * 33] * gb[2], s[7 * 33] * gb[3]);
        *(u32x4*)(WT + (size_t)(drow0 + n) * K + k0 + 8 * c) = o; }
    asm volatile("s_waitcnt lgkmcnt(0)" ::: "memory");
}

constexpr int I_IN = (DM / 64) * (DIN / 32), I_OUT = (DM / 64) * (DM / 32), I_UP = (DM / 64) * (DUP / 32), I_DN = (DFF / 64) * (DM / 32), I_L = I_IN + I_OUT + I_UP + I_DN;
__device__ __forceinline__ void convert_weights(LAS unsigned char* lds, CParams P, int l, int r0, int r1, int worker, int nworkers) {
    int tid_ = threadIdx.x; asm volatile("" : "+v"(tid_));
    const int tid = tid_, lane = tid & 63, wave = tid >> 6;
    unsigned char* ws = P->ws;
    LAS float* scr = (LAS float*)(lds + wave * 16384);
    for (int it = r0 + worker * NWAVES + wave; it < r1; it += nworkers * NWAVES) {
        int r = it;
        if (r < I_IN) { transpose_item(P->in[5] + (size_t)l * DM * DIN, DM, DIN, (bf16_t*)(ws + WS_WIN + l * 20 * MiB), P->in[4] + l * DM, 2, scr, r, lane); continue; } r -= I_IN;
        if (r < I_OUT) { const int k0 = 64 * (r / (DM / 32)); const float* g = k0 < DA ? P->in[10] + l * DA : P->in[11] + l * DA - DA;
            transpose_item(P->in[12] + (size_t)l * DM * DM, DM, DM, (bf16_t*)(ws + WS_WOUT + l * 8 * MiB), g, 0, scr, r, lane); continue; } r -= I_OUT;
        if (r < I_UP) { transpose_item(P->in[14] + (size_t)l * DM * DUP, DM, DUP, (bf16_t*)(ws + WS_WUP + l * 44 * MiB), P->in[13] + l * DM, 1, scr, r, lane); continue; } r -= I_UP;
        transpose_item(P->in[16] + (size_t)l * DFF * DM, DFF, DM, (bf16_t*)(ws + WS_WDN + l * 22 * MiB), nullptr, 0, scr, r, lane);
    }
}

__device__ __forceinline__ void prologue_phase(LAS unsigned char* lds, CParams P) {
    int tid_ = threadIdx.x; asm volatile("" : "+v"(tid_));
    const int tid = tid_, lane = tid & 63, wave = tid >> 6;
    const int gw = blockIdx.x * NWAVES + wave, NGW = gridDim.x * NWAVES;
    unsigned char* ws = P->ws;
    LAS float* scr = (LAS float*)(lds + wave * 16384);
    if (gridDim.x == 256) convert_weights(lds, P, 0, 0, I_IN, blockIdx.x, gridDim.x);
    else { convert_weights(lds, P, 0, 0, I_L, blockIdx.x, gridDim.x); convert_weights(lds, P, 1, 0, I_L, blockIdx.x, gridDim.x); }
    float* ss = (float*)(ws + WS_SS); bf16_t* xb = (bf16_t*)(ws + WS_XB);
    for (int m = gw; m < MROWS; m += NGW) {
        const float* xr = m < NPROMPT ? P->in[0] + (size_t)m * DM : P->in[1] + (size_t)(m - NPROMPT) * DM;
        f32x4 v[8]; float s = 0.f;
#pragma unroll
        for (int j = 0; j < 8; ++j) { v[j] = ((const f32x4*)xr)[lane + 64 * j]; s += (v[j][0] * v[j][0] + v[j][1] * v[j][1]) + (v[j][2] * v[j][2] + v[j][3] * v[j][3]); }
        s = wave_sum(s); if (lane == 0) ss[m] = s;
#pragma unroll
        for (int j = 0; j < 8; ++j) { u32x2 w; w.x = pk2(v[j][0], v[j][1]); w.y = pk2(v[j][2], v[j][3]); ((u32x2*)(xb + (size_t)m * DM))[lane + 64 * j] = w; }
    }
    const int gt = blockIdx.x * NTHREADS + tid, NGT = gridDim.x * NTHREADS;
    for (int i = gt; i < 4 * MROWS; i += NGT) ss[MROWS + i] = 0.f;
    bf16_t* wsb = (bf16_t*)(ws + WS_WSB);
    for (int i = gt; i < 2 * 8 * 128 * 128 / 2; i += NGT) { const float2 w = ((const float2*)P->in[7])[i]; ((unsigned*)wsb)[i] = pk2(w.x, w.y); }
}

__device__ __forceinline__ unsigned off_b(unsigned row, unsigned ch) { return 256u * row + 16u * (ch ^ (((row & 3) << 2) | ((row >> 2) & 3))); }
__device__ __forceinline__ unsigned tr_read_addr(unsigned lane, unsigned c, unsigned ks, unsigned t) {
    const unsigned h = lane >> 5, blk = (lane >> 4) & 1, q = (lane & 15) >> 2, p = lane & 3;
    return off_b(16 * ks + 8 * h + 4 * t + q, 4 * c + 2 * blk + (p >> 1)) + 8 * (p & 1);
}
__device__ __forceinline__ void mixer_phase(LAS unsigned char* lds, CParams P, int l) {
    int tid_ = threadIdx.x; asm volatile("" : "+v"(tid_));
    const int tid = tid_, lane = tid & 63, wave = __builtin_amdgcn_readfirstlane(tid >> 6);
    unsigned char* ws = P->ws;
    const bf16_t* proj = (const bf16_t*)(ws + WS_PROJ); bf16_t* mix = (bf16_t*)(ws + WS_MIX);
    const bf16_t* wsb = (const bf16_t*)(ws + WS_WSB) + (size_t)l * 8 * 128 * 128;
    const float* vg = P->in[6] + l * DA; const float* bs = P->in[8] + l * 8 * 128; const float* scw = P->in[9] + l * 3 * 1024; const float* st_s = P->in[2] + (size_t)l * 8 * 2 * 1024;
    float* oSV = P->out + O_SV + (size_t)l * 8 * 64 * 1024; float* oPS = P->out + O_PS + (size_t)l * 2 * 2 * 1024; float* oSS = P->out + O_SS + (size_t)l * 8 * 2 * 1024;
    LAS float* SSA = (LAS float*)(lds + 65536);
    LAS float* SSB = (LAS float*)(lds + 65536 + 2048);
    LAS float* RA = (LAS float*)(lds + 65536 + 3072);
    LAS float* RB = (LAS float*)(lds + 65536 + 3584);
    const unsigned ldsbase = (unsigned)(size_t)lds;
    const int tb = wave & 3, dh = wave >> 2;
    for (int cu = blockIdx.x; cu < MROWS / 128; cu += gridDim.x) {
        const int row0 = cu * 128; const bool sample = row0 >= NPROMPT;
        float ssA = 0.f;
        const int wt0 = sample ? 32 * (tb & 1) : 32 * tb;
        const int ks_lo = (sample && tb >= 2) ? 4 : 0, ks_hi = (tb >= 2) ? 8 : 4, wcs = (sample && tb >= 2) ? -64 : 0;
        const int t_abs = row0 + 32 * tb + (lane & 31);
        const int tpos = sample ? ((32 * tb + (lane & 31)) & 63) : (32 * tb + (lane & 31));
        const int ch = tid & 15;
        u32x4 raw[4]; f32x4 vga, vgb;
#pragma unroll
        for (int i = 0; i < 4; ++i) raw[i] = *(const u32x4*)(proj + pg8::proj_off(row0 + (tid >> 4) + 32 * i, 1024 + 8 * ch));
        vga = *(const f32x4*)(vg + 8 * ch); vgb = *(const f32x4*)(vg + 8 * ch + 4);
        for (int h = 0; h < 8; ++h) {
            LAS unsigned char* img = lds + (h & 1) * 32768; const unsigned imgbase = ldsbase + (h & 1) * 32768;
            bf16x8 wf[8];
            const bf16_t* wrow = wsb + ((size_t)(h * 128 + wt0 + (lane & 31))) * 128 + wcs + 8 * (lane >> 5);
#pragma unroll
            for (int ks = 0; ks < 8; ++ks) if (ks >= ks_lo && ks < ks_hi) wf[ks] = *(const bf16x8*)(wrow + 16 * ks);
            u32x2 ur[2][4];
#pragma unroll
            for (int nb = 0; nb < 2; ++nb)
#pragma unroll
                for (int rq = 0; rq < 4; ++rq) ur[nb][rq] = *(const u32x2*)(proj + pg8::proj_off(t_abs, 128 * h + 32 * (2 * dh + nb) + 8 * rq + 4 * (lane >> 5)));
            const float bias = bs[h * 128 + tpos];
            const int hn = h < 7 ? h + 1 : 7;
            u32x4 rawn[4]; f32x4 vgan, vgbn;
#pragma unroll
            for (int i = 0; i < 4; ++i) rawn[i] = *(const u32x4*)(proj + pg8::proj_off(row0 + (tid >> 4) + 32 * i, 1024 + 128 * hn + 8 * ch));
            vgan = *(const f32x4*)(vg + 128 * hn + 8 * ch); vgbn = *(const f32x4*)(vg + 128 * hn + 8 * ch + 4);
#pragma unroll
            for (int i = 0; i < 4; ++i) { const int row = (tid >> 4) + 32 * i; const u32x4 rw = raw[i];
                float g[8]; g[0] = gelu_tanh(pg8::bf_lo(rw.x)); g[1] = gelu_tanh(pg8::bf_hi(rw.x)); g[2] = gelu_tanh(pg8::bf_lo(rw.y)); g[3] = gelu_tanh(pg8::bf_hi(rw.y));
                g[4] = gelu_tanh(pg8::bf_lo(rw.z)); g[5] = gelu_tanh(pg8::bf_hi(rw.z)); g[6] = gelu_tanh(pg8::bf_lo(rw.w)); g[7] = gelu_tanh(pg8::bf_hi(rw.w));
                float s = 0.f;
#pragma unroll
                for (int j = 0; j < 8; ++j) s += g[j] * g[j];
                s += __shfl_xor(s, 1); s += __shfl_xor(s, 2); s += __shfl_xor(s, 4); s += __shfl_xor(s, 8);
                const float rn = pg8::rs_of(s, 1.0f / 128.0f);
                f32x4 o0, o1;
#pragma unroll
                for (int j = 0; j < 4; ++j) { o0[j] = g[j] * rn * vga[j]; o1[j] = g[4 + j] * rn * vgb[j]; }
                if (sample) { float* d = oSV + (size_t)(row0 + row - NPROMPT) * 1024 + 128 * h + 8 * ch; *(f32x4*)d = o0; *(f32x4*)(d + 4) = o1; }
                u32x4 w; w.x = pg8::cvt_pk_bf16(o0[0], o0[1]); w.y = pg8::cvt_pk_bf16(o0[2], o0[3]); w.z = pg8::cvt_pk_bf16(o1[0], o1[1]); w.w = pg8::cvt_pk_bf16(o1[2], o1[3]);
                *(LAS u32x4*)(img + off_b(row, ch)) = w; }
            __syncthreads();
            f32x16 acc[2];
#pragma unroll
            for (int nb = 0; nb < 2; ++nb)
#pragma unroll
                for (int r = 0; r < 16; ++r) acc[nb][r] = 0.f;
            const unsigned a00 = imgbase + tr_read_addr(lane, 2 * dh, 0, 0), a01 = imgbase + tr_read_addr(lane, 2 * dh, 0, 1);
            const unsigned a10 = imgbase + tr_read_addr(lane, 2 * dh + 1, 0, 0), a11 = imgbase + tr_read_addr(lane, 2 * dh + 1, 0, 1);
#pragma unroll
            for (int ks = 0; ks < 8; ++ks) if (ks >= ks_lo && ks < ks_hi) {
                s16x4 f00, f01, f10, f11; const unsigned ko = 4096u * ks;
                asm volatile("ds_read_b64_tr_b16 %0, %4\n\tds_read_b64_tr_b16 %1, %5\n\tds_read_b64_tr_b16 %2, %6\n\tds_read_b64_tr_b16 %3, %7\n\ts_waitcnt lgkmcnt(0)"
                             : "=&v"(f00), "=&v"(f01), "=&v"(f10), "=&v"(f11) : "v"(a00 + ko), "v"(a01 + ko), "v"(a10 + ko), "v"(a11 + ko) : "memory");
                const bf16x8 fa = __builtin_shufflevector(f00, f01, 0, 1, 2, 3, 4, 5, 6, 7), fb = __builtin_shufflevector(f10, f11, 0, 1, 2, 3, 4, 5, 6, 7);
                acc[0] = __builtin_amdgcn_mfma_f32_32x32x16_bf16(fa, wf[ks], acc[0], 0, 0, 0);
                acc[1] = __builtin_amdgcn_mfma_f32_32x32x16_bf16(fb, wf[ks], acc[1], 0, 0, 0);
            }
#pragma unroll
            for (int nb = 0; nb < 2; ++nb)
#pragma unroll
                for (int rq = 0; rq < 4; ++rq) { const int d0 = 32 * (2 * dh + nb) + 8 * rq + 4 * (lane >> 5);
                    const u32x2 rw = ur[nb][rq];
                    const float a0 = gelu_tanh(pg8::bf_lo(rw.x)) * (acc[nb][4 * rq + 0] + bias), a1 = gelu_tanh(pg8::bf_hi(rw.x)) * (acc[nb][4 * rq + 1] + bias);
                    const float a2 = gelu_tanh(pg8::bf_lo(rw.y)) * (acc[nb][4 * rq + 2] + bias), a3 = gelu_tanh(pg8::bf_hi(rw.y)) * (acc[nb][4 * rq + 3] + bias);
                    ssA += (a0 * a0 + a1 * a1) + (a2 * a2 + a3 * a3);
                    u32x2 w; w.x = pg8::cvt_pk_bf16(a0, a1); w.y = pg8::cvt_pk_bf16(a2, a3); *(u32x2*)(mix + (size_t)t_abs * DM + 128 * h + d0) = w; }
#pragma unroll
            for (int i = 0; i < 4; ++i) raw[i] = rawn[i];
            vga = vgan; vgb = vgbn;
        }
        SSA[(dh * 2 + (lane >> 5)) * 128 + 32 * tb + (lane & 31)] = ssA;
        {
            const int cgp = tid & 127, strip = tid >> 7, c0 = 8 * cgp, r0 = row0 + 32 * strip;
            float w0[8], w1[8], w2[8], q1[8], q2[8];
#pragma unroll
            for (int j = 0; j < 8; ++j) { w0[j] = scw[c0 + j]; w1[j] = scw[1024 + c0 + j]; w2[j] = scw[2048 + c0 + j]; }
            const bool seqstart = sample ? ((strip & 1) == 0) : (strip == 0 && (cu & 127) == 0);
            const int sb_ = sample ? (r0 - NPROMPT) / 64 : 0;
            if (seqstart) {
                if (sample) {
#pragma unroll
                    for (int j = 0; j < 8; ++j) { q2[j] = st_s[(sb_ * 2 + 0) * 1024 + c0 + j]; q1[j] = st_s[(sb_ * 2 + 1) * 1024 + c0 + j]; }
                } else {
#pragma unroll
                    for (int j = 0; j < 8; ++j) { q2[j] = 0.f; q1[j] = 0.f; }
                }
            } else {
                const u32x4 c2 = *(const u32x4*)(proj + pg8::proj_off(r0 - 2, 3072 + c0)), c1 = *(const u32x4*)(proj + pg8::proj_off(r0 - 1, 3072 + c0)); const u32x4 h2 = {0x3f803f80u, 0x3f803f80u, 0x3f803f80u, 0x3f803f80u}, h1 = h2;
                q2[0] = pg8::bf_lo(c2.x) * pg8::bf_lo(h2.x); q2[1] = pg8::bf_hi(c2.x) * pg8::bf_hi(h2.x); q2[2] = pg8::bf_lo(c2.y) * pg8::bf_lo(h2.y); q2[3] = pg8::bf_hi(c2.y) * pg8::bf_hi(h2.y);
                q2[4] = pg8::bf_lo(c2.z) * pg8::bf_lo(h2.z); q2[5] = pg8::bf_hi(c2.z) * pg8::bf_hi(h2.z); q2[6] = pg8::bf_lo(c2.w) * pg8::bf_lo(h2.w); q2[7] = pg8::bf_hi(c2.w) * pg8::bf_hi(h2.w);
                q1[0] = pg8::bf_lo(c1.x) * pg8::bf_lo(h1.x); q1[1] = pg8::bf_hi(c1.x) * pg8::bf_hi(h1.x); q1[2] = pg8::bf_lo(c1.y) * pg8::bf_lo(h1.y); q1[3] = pg8::bf_hi(c1.y) * pg8::bf_hi(h1.y);
                q1[4] = pg8::bf_lo(c1.z) * pg8::bf_lo(h1.z); q1[5] = pg8::bf_hi(c1.z) * pg8::bf_hi(h1.z); q1[6] = pg8::bf_lo(c1.w) * pg8::bf_lo(h1.w); q1[7] = pg8::bf_hi(c1.w) * pg8::bf_hi(h1.w);
            }
            const bool st_out = sample ? ((strip & 1) == 1) : (strip == 3 && (cu & 127) == 127);
            float* st_dst = sample ? oSS + (size_t)sb_ * 2 * 1024 + c0 : oPS + (size_t)(cu >> 7) * 2 * 1024 + c0;
#pragma unroll 4
            for (int i = 0; i < 32; ++i) {
                const bf16_t* pr = proj + pg8::proj_off(r0 + i, 2048 + c0);
                const u32x4 gb = *(const u32x4*)pr, gc = *(const u32x4*)(pr + 8 * 16384);     const u32x4 hi = {0x3f803f80u, 0x3f803f80u, 0x3f803f80u, 0x3f803f80u};
                float q[8], b[8], g[8];
                q[0] = pg8::bf_lo(gc.x) * pg8::bf_lo(hi.x); q[1] = pg8::bf_hi(gc.x) * pg8::bf_hi(hi.x); q[2] = pg8::bf_lo(gc.y) * pg8::bf_lo(hi.y); q[3] = pg8::bf_hi(gc.y) * pg8::bf_hi(hi.y);
                q[4] = pg8::bf_lo(gc.z) * pg8::bf_lo(hi.z); q[5] = pg8::bf_hi(gc.z) * pg8::bf_hi(hi.z); q[6] = pg8::bf_lo(gc.w) * pg8::bf_lo(hi.w); q[7] = pg8::bf_hi(gc.w) * pg8::bf_hi(hi.w);
                g[0] = pg8::bf_lo(gb.x); g[1] = pg8::bf_hi(gb.x); g[2] = pg8::bf_lo(gb.y); g[3] = pg8::bf_hi(gb.y); g[4] = pg8::bf_lo(gb.z); g[5] = pg8::bf_hi(gb.z); g[6] = pg8::bf_lo(gb.w); g[7] = pg8::bf_hi(gb.w);
                float s = 0.f;
#pragma unroll
                for (int j = 0; j < 8; ++j) { b[j] = g[j] * (w0[j] * q2[j] + w1[j] * q1[j] + w2[j] * q[j]); s += b[j] * b[j]; }
                u32x4 w; w.x = pg8::cvt_pk_bf16(b[0], b[1]); w.y = pg8::cvt_pk_bf16(b[2], b[3]); w.z = pg8::cvt_pk_bf16(b[4], b[5]); w.w = pg8::cvt_pk_bf16(b[6], b[7]);
                *(u32x4*)(mix + (size_t)(r0 + i) * DM + 1024 + c0) = w;
                if (st_out && i >= 30) { float* d = st_dst + (i - 30) * 1024; *(f32x4*)d = (f32x4){q[0], q[1], q[2], q[3]}; *(f32x4*)(d + 4) = (f32x4){q[4], q[5], q[6], q[7]}; }
                s = wave_sum(s);
                if (lane == 0) SSB[((tid >> 6) & 1) * 128 + 32 * strip + i] = s;
#pragma unroll
                for (int j = 0; j < 8; ++j) { q2[j] = q1[j]; q1[j] = q[j]; }
            }
        }
        __syncthreads();
        if (tid < 128) { const float ra = pg8::rs_of(SSA[tid] + SSA[128 + tid] + SSA[256 + tid] + SSA[384 + tid], 1.0f / 1024.0f), rb = pg8::rs_of(SSB[tid] + SSB[128 + tid], 1.0f / 1024.0f);
            float2* rab = (float2*)(ws + WS_RAB); rab[row0 + tid] = make_float2(ra / rb, rb); }
        __syncthreads();
    }
}

__device__ __forceinline__ void fixup_phase(CParams P, int l) {
    unsigned char* ws = P->ws; const float* sb = (const float*)(ws + WS_SB); bf16_t* act = (bf16_t*)(ws + WS_ACT);
    const float* cw = P->in[15] + (size_t)l * 3 * DUP; const float* st_f = P->in[3] + (size_t)l * 8 * 2 * DUP;
    int tid_ = threadIdx.x; asm volatile("" : "+v"(tid_));
    const int gt = blockIdx.x * NTHREADS + tid_, NGT = gridDim.x * NTHREADS;
    constexpr int NQ = DFF / 4;
    for (int it = gt; it < NBLK64 * 2 * NQ; it += NGT) {
        const int cq = it % NQ, bj = it / NQ, j = bj & 1, blk = bj >> 1, c = 4 * cq;
        const f32x4 z = {0.f, 0.f, 0.f, 0.f};
        f32x4 xg[4], xv[4];
        const float* s0 = sb + (size_t)blk * 4 * DUP + c;
        xg[2] = *(const f32x4*)s0; xv[2] = *(const f32x4*)(s0 + DFF); xg[3] = *(const f32x4*)(s0 + DUP); xv[3] = *(const f32x4*)(s0 + DUP + DFF);
        if (blk >= 512) { const float* sp = st_f + (size_t)(blk - 512) * 2 * DUP + c; xg[0] = *(const f32x4*)sp; xv[0] = *(const f32x4*)(sp + DFF); xg[1] = *(const f32x4*)(sp + DUP); xv[1] = *(const f32x4*)(sp + DUP + DFF); }
        else if ((blk & 255) == 0) { xg[0] = z; xv[0] = z; xg[1] = z; xv[1] = z; }
        else { const float* sp = s0 - 2 * DUP; xg[0] = *(const f32x4*)sp; xv[0] = *(const f32x4*)(sp + DFF); xg[1] = *(const f32x4*)(sp + DUP); xv[1] = *(const f32x4*)(sp + DUP + DFF); }
        const f32x4 wg0 = *(const f32x4*)(cw + c), wg1 = *(const f32x4*)(cw + DUP + c), wg2 = *(const f32x4*)(cw + 2 * DUP + c);
        const f32x4 wv0 = *(const f32x4*)(cw + DFF + c), wv1 = *(const f32x4*)(cw + DUP + DFF + c), wv2 = *(const f32x4*)(cw + 2 * DUP + DFF + c);
        const f32x4 tg0 = j ? xg[1] : xg[0], tg1 = j ? xg[2] : xg[1], tg2 = j ? xg[3] : xg[2], tv0 = j ? xv[1] : xv[0], tv1 = j ? xv[2] : xv[1], tv2 = j ? xv[3] : xv[2];
        const f32x4 G = wg0 * tg0 + wg1 * tg1 + wg2 * tg2, V = wv0 * tv0 + wv1 * tv1 + wv2 * tv2;
        f32x4 a;
#pragma unroll
        for (int e = 0; e < 4; ++e) a[e] = G[e] * V[e] * pg8::sigmoidf_fast(G[e]);
        u32x2 w; w.x = pg8::cvt_pk_bf16(a[0], a[1]); w.y = pg8::cvt_pk_bf16(a[2], a[3]);
        *(u32x2*)(act + (size_t)(blk * 64 + j) * DFF + c) = w;
    }
    float* oPF = P->out + O_PF + (size_t)l * 2 * 2 * DUP; float* oSF = P->out + O_SF + (size_t)l * 8 * 2 * DUP;
    constexpr int NQ2 = DUP / 4;
    for (int it = gt; it < 10 * 2 * NQ2; it += NGT) { const int cq = it % NQ2, sj = it / NQ2, j = sj & 1, s = sj >> 1;
        const int blk = s < 2 ? 256 * s + 255 : 512 + (s - 2);
        const f32x4 v = *(const f32x4*)(sb + ((size_t)blk * 4 + 2 + j) * DUP + 4 * cq);
        float* d = s < 2 ? oPF + ((size_t)s * 2 + j) * DUP : oSF + ((size_t)(s - 2) * 2 + j) * DUP;
        *(f32x4*)(d + 4 * cq) = v; }
}

__device__ __forceinline__ void finalize_phase(CParams P, int ssidx, int nsplit, bool base_in, bool last) {
    int tid_ = threadIdx.x; asm volatile("" : "+v"(tid_));
    const int tid = tid_, lane = tid & 63, wave = tid >> 6;
    const int gw = blockIdx.x * NWAVES + wave, NGW = gridDim.x * NWAVES;
    float* ss = (float*)(P->ws + WS_SS) + (size_t)ssidx * MROWS; bf16_t* xb = (bf16_t*)(P->ws + WS_XB); float* out = P->out;
    const float* part = (const float*)(P->ws + WS_PART); const float* base = P->in[1];
    for (int ms = gw; ms < MROWS - NPROMPT; ms += NGW) { const int m = NPROMPT + ms;
        f32x4 v[8]; float s = 0.f;
        if (base_in) {
#pragma unroll
            for (int j = 0; j < 8; ++j) v[j] = ((const f32x4*)(base + (size_t)ms * DM))[lane + 64 * j];
        } else {
#pragma unroll
            for (int j = 0; j < 8; ++j) { const u32x2 h = ((const u32x2*)(xb + (size_t)m * DM))[lane + 64 * j]; v[j] = (f32x4){pg8::bf_lo(h.x), pg8::bf_hi(h.x), pg8::bf_lo(h.y), pg8::bf_hi(h.y)}; }
        }
        for (int sl = 0; sl < nsplit; ++sl) { const u32x2* pr = (const u32x2*)((const bf16_t*)part + ((size_t)sl * (MROWS - NPROMPT) + ms) * DM);
#pragma unroll
            for (int j = 0; j < 8; ++j) { const u32x2 h = pr[lane + 64 * j]; v[j] += (f32x4){pg8::bf_lo(h.x), pg8::bf_hi(h.x), pg8::bf_lo(h.y), pg8::bf_hi(h.y)}; } }
#pragma unroll
        for (int j = 0; j < 8; ++j) { if (last) ((f32x4*)(out + (size_t)m * DM))[lane + 64 * j] = v[j]; s += (v[j][0] * v[j][0] + v[j][1] * v[j][1]) + (v[j][2] * v[j][2] + v[j][3] * v[j][3]); }
        s = wave_sum(s); if (lane == 0) ss[m] = s;
        if (!last) {
#pragma unroll
            for (int j = 0; j < 8; ++j) { u32x2 w; w.x = pk2(v[j][0], v[j][1]); w.y = pk2(v[j][2], v[j][3]); ((u32x2*)(xb + (size_t)m * DM))[lane + 64 * j] = w; } }
    }
}

__device__ __forceinline__ void final_phase(CParams P) {
    int tid_ = threadIdx.x; asm volatile("" : "+v"(tid_));
    const int tid = tid_, lane = tid & 63, wave = tid >> 6;
    const int gw = blockIdx.x * NWAVES + wave, NGW = gridDim.x * NWAVES;
    const float* g = P->in[17]; float* out = P->out; const bf16_t* xb = (const bf16_t*)(P->ws + WS_XB);
    f32x4 gv[8];
#pragma unroll
    for (int j = 0; j < 8; ++j) gv[j] = ((const f32x4*)g)[lane + 64 * j];
    for (int m = gw; m < MROWS; m += NGW) { f32x4* xr = (f32x4*)(out + (size_t)m * DM); f32x4 v[8]; float s = 0.f;
#pragma unroll
        for (int j = 0; j < 8; ++j) { const u32x2 h = ((const u32x2*)(xb + (size_t)m * DM))[lane + 64 * j]; v[j] = (f32x4){pg8::bf_lo(h.x), pg8::bf_hi(h.x), pg8::bf_lo(h.y), pg8::bf_hi(h.y)};
            s += (v[j][0] * v[j][0] + v[j][1] * v[j][1]) + (v[j][2] * v[j][2] + v[j][3] * v[j][3]); }
        const float rs = pg8::rs_of(wave_sum(s), 1.0f / DM);
#pragma unroll
        for (int j = 0; j < 8; ++j) xr[lane + 64 * j] = v[j] * rs * gv[j]; }
}

constexpr size_t WS_BAR = 768 * 1024;
#define RLX_AGENT __ATOMIC_RELAXED, __HIP_MEMORY_SCOPE_AGENT
#define XB_TMO      128
#define XB_XCNT(j)  (256  + 64 * (j))
#define XB_XSUB(j)  (1280 + 64 * (j))
#define XB_XGEN(j)  (2304 + 64 * (j))
#define XB_TOP      3328
#define XB_TOPGEN   3392
#define XCD_BAR_WORDS 3456
#define XB_SPIN_CAP (1u << 18)

__device__ __forceinline__ unsigned xb_ld(unsigned* p)              { return __hip_atomic_load(p, __ATOMIC_RELAXED, __HIP_MEMORY_SCOPE_AGENT); }
__device__ __forceinline__ unsigned xb_add(unsigned* p, unsigned v) { return __hip_atomic_fetch_add(p, v, __ATOMIC_RELAXED, __HIP_MEMORY_SCOPE_AGENT); }
__device__ __forceinline__ unsigned xb_xcc_id() { return (unsigned)__builtin_amdgcn_s_getreg((3 << 11) | 20) & 0xFu; }
#define XB_SPIN(cond, bar) do { unsigned _sp = 0; while (cond) { __builtin_amdgcn_s_sleep(1); \
    if ((++_sp & 255u) == 0u) { if (xb_ld(&(bar)[XB_TMO])) break; if (_sp > XB_SPIN_CAP) { atomicAdd(&(bar)[XB_TMO], 1u); break; } } } } while (0)

struct XcdBarrier {
    unsigned* bar; unsigned x;
    volatile LAS unsigned* st;
};

__device__ __forceinline__ XcdBarrier xcd_barrier_post(unsigned* bar, volatile LAS unsigned* st) {
    XcdBarrier b; b.bar = bar; b.x = xb_xcc_id(); b.st = st;
    if (threadIdx.x == 0) (void)xb_add(&bar[XB_XCNT(b.x)], 1u);
    return b;
}
__device__ __forceinline__ void xcd_barrier_complete(unsigned* bar, unsigned x, unsigned& nloc, unsigned& nx) {
    const unsigned G = gridDim.x * gridDim.y * gridDim.z;
    unsigned sum, cnt, mine, sp = 0u;
    for (;;) {
        sum = 0u; cnt = 0u; mine = 0u;
#pragma unroll
        for (unsigned j = 0; j < 16; ++j) { const unsigned c = xb_ld(&bar[XB_XCNT(j)]); sum += c; cnt += (c > 0u) ? 1u : 0u; mine = (j == x) ? c : mine; }
        if (sum == G) break;
        __builtin_amdgcn_s_sleep(1);
        if ((++sp & 255u) == 0u) { if (xb_ld(&bar[XB_TMO])) break; if (sp > XB_SPIN_CAP) { atomicAdd(&bar[XB_TMO], 1u); break; } }
    }
    nloc = mine > 0u ? mine : 1u; nx = cnt > 0u ? cnt : 1u;
}

__device__ __forceinline__ void xcd_barrier(const XcdBarrier& b) {
    asm volatile("s_waitcnt vmcnt(0)" ::: "memory");
    __syncthreads();
    if (threadIdx.x == 0) {
        unsigned* bar = b.bar;
        __builtin_amdgcn_s_waitcnt(0);
        unsigned nloc = b.st[0], nx = b.st[1];
        if (nloc == 0u) { xcd_barrier_complete(bar, b.x, nloc, nx); b.st[0] = nloc; b.st[1] = nx; }
        const unsigned old = xb_add(&bar[XB_XSUB(b.x)], 1u);
        const unsigned gen = old / nloc;
        if (old + 1u == (gen + 1u) * nloc) {
            __builtin_amdgcn_fence(__ATOMIC_RELEASE, "agent");
            asm volatile("s_waitcnt vmcnt(0)" ::: "memory");
            const unsigned og = xb_add(&bar[XB_TOP], 1u);
            const unsigned tg = og / nx;
            if (og + 1u == (tg + 1u) * nx) xb_add(&bar[XB_TOPGEN], 1u);
            else XB_SPIN(xb_ld(&bar[XB_TOPGEN]) == tg, bar);
            __builtin_amdgcn_fence(__ATOMIC_ACQUIRE, "agent");
            xb_add(&bar[XB_XGEN(b.x)], 1u);
            asm volatile("s_waitcnt vmcnt(0)" ::: "memory");
        } else {
            XB_SPIN(xb_ld(&bar[XB_XGEN(b.x)]) == gen, bar);
            __builtin_amdgcn_fence(__ATOMIC_ACQUIRE, "agent");
            asm volatile("s_waitcnt vmcnt(0)" ::: "memory");
        }
    }
    __syncthreads();
}

constexpr int N_PHASES = 14;
__global__ void __launch_bounds__(NTHREADS, 2) mk_fwd(Params Parg) {
    extern __shared__ __attribute__((aligned(16))) unsigned char lds_raw[];
    LAS unsigned char* lds = (LAS unsigned char*)lds_raw;
    cg::grid_group grid = cg::this_grid();
    { CParams P = params(); if (P->ph_lo > P->ph_hi) grid.sync(); }
    volatile LAS unsigned* bst = (volatile LAS unsigned*)(lds + 131072 + 1024);
    if (threadIdx.x < 2) bst[threadIdx.x] = 0u;
    __syncthreads();
    { CParams P = params(); (void)xcd_barrier_post((unsigned*)(P->ws + WS_BAR), bst); }
#ifdef ONLY
#define IN(k) ((k) == ONLY)
#else
#define IN(k) true
#endif
#ifdef USE_CG_SYNC
#define GRID_BAR() grid.sync()
#else
#define GRID_BAR() do { XcdBarrier b_; b_.bar = (unsigned*)(params()->ws + WS_BAR); b_.x = xb_xcc_id(); b_.st = (volatile LAS unsigned*)(lds + 131072 + 1024); xcd_barrier(b_); } while (0)
#endif
#ifndef REP_P0
#define REP_P0 1
#endif
#ifndef REP_MIX
#define REP_MIX 1
#endif
#ifndef REP_G1
#define REP_G1 1
#endif
#ifndef REP_G3
#define REP_G3 1
#endif
    if (IN(0)) { for (int rep = 0; rep < REP_P0; ++rep) { prologue_phase(lds, params()); __syncthreads(); } }
    GRID_BAR();
#ifdef REP_SYNC
    for (int rep = 0; rep < REP_SYNC; ++rep) GRID_BAR();
#endif
#pragma unroll
    for (int l = 0; l < 2; ++l) {
        if (IN(1)) {
            CParams P = params(); unsigned char* ws = P->ws; float* ss = (float*)(ws + WS_SS);
            pg8::Gemm g{(const bf16_t*)(ws + WS_XB), (const bf16_t*)(ws + WS_WIN + l * 20 * MiB), MROWS, DIN, DM}; pg8::StaticOrder S; S.init(MROWS, DIN, gridDim.x, blockIdx.x);
            pg8::EpiProj E{(bf16_t*)(ws + WS_PROJ), ss + (l == 0 ? 0 : 2 * MROWS)};
            for (int rep = 0; rep < REP_G1; ++rep) pg8::gemm_phase<pg8::EpiProj, pg8::StaticOrder>(lds, g, S, E, nullptr);
            if (l == 0 && gridDim.x == 256 && blockIdx.x >= 40) { __syncthreads(); convert_weights(lds, P, 0, I_IN, I_IN + I_OUT + I_UP, blockIdx.x - 40, 216); }
        }
        GRID_BAR();
        if (IN(2)) { for (int rep = 0; rep < REP_MIX; ++rep) { mixer_phase(lds, params(), l); __syncthreads(); }
            if (gridDim.x == 256 && blockIdx.x >= 4) {
                if (l == 0) { convert_weights(lds, params(), 0, I_IN + I_OUT + I_UP, I_L, blockIdx.x - 4, 252); convert_weights(lds, params(), 1, 0, I_IN + I_OUT, blockIdx.x - 4, 252); }
                else convert_weights(lds, params(), 1, I_IN + I_OUT + I_UP, I_L, blockIdx.x - 4, 252); } }
        GRID_BAR();
        if (IN(3)) {
            CParams P = params(); unsigned char* ws = P->ws; float* ss = (float*)(ws + WS_SS); float* out = P->out;
            pg8::Gemm g{(const bf16_t*)(ws + WS_MIX), (const bf16_t*)(ws + WS_WOUT + l * 8 * MiB), MROWS, DM, DM}; pg8::SplitOrder S; S.init(DM, gridDim.x, blockIdx.x, 4, 8);
            pg8::EpiResid<true> E{nullptr, nullptr, nullptr, (bf16_t*)(ws + WS_XB), ss + (1 + 2 * l) * MROWS, (float*)(ws + WS_PART), (const float*)(ws + WS_RAB), 1};
            pg8::gemm_phase<pg8::EpiResid<true>, pg8::SplitOrder>(lds, g, S, E, nullptr);
        }
        GRID_BAR();
        if (IN(4)) finalize_phase(params(), 1 + 2 * l, 4, false, false);
        GRID_BAR();
        if (IN(5)) {
            CParams P = params(); unsigned char* ws = P->ws; float* ss = (float*)(ws + WS_SS);
            pg8::Gemm g{(const bf16_t*)(ws + WS_XB), (const bf16_t*)(ws + WS_WUP + l * 44 * MiB), MROWS, DUP, DM}; pg8::StaticOrder S; S.init(MROWS, DUP, gridDim.x, blockIdx.x);
            pg8::EpiFfn E{(bf16_t*)(ws + WS_ACT), ss + (1 + 2 * l) * MROWS, P->in[15] + (size_t)l * 3 * DUP, (float*)(ws + WS_SB), (LAS float*)(lds + 131072 + 2048)};
            for (int rep = 0; rep < REP_G3; ++rep) pg8::gemm_phase<pg8::EpiFfn, pg8::StaticOrder>(lds, g, S, E, nullptr);
            if (l == 0 && gridDim.x == 256 && blockIdx.x >= 88) { __syncthreads(); convert_weights(lds, P, 1, I_IN + I_OUT, I_IN + I_OUT + I_UP, blockIdx.x - 88, 168); }
        }
        GRID_BAR();
        if (IN(6)) fixup_phase(params(), l);
        GRID_BAR();
        if (IN(7)) {
            CParams P = params(); unsigned char* ws = P->ws; float* ss = (float*)(ws + WS_SS); float* out = P->out;
            pg8::Gemm g{(const bf16_t*)(ws + WS_ACT), (const bf16_t*)(ws + WS_WDN + l * 22 * MiB), MROWS, DM, DFF}; pg8::SplitOrder S; S.init(DM, gridDim.x, blockIdx.x, 11, 8);
            pg8::EpiResid<false> E{nullptr, nullptr, nullptr, (bf16_t*)(ws + WS_XB), l == 0 ? ss + 2 * MROWS : nullptr, (float*)(ws + WS_PART), nullptr, 1};
            pg8::gemm_phase<pg8::EpiResid<false>, pg8::SplitOrder>(lds, g, S, E, nullptr);
        }
        GRID_BAR();
        if (IN(8)) finalize_phase(params(), 2, 11, false, false);
        GRID_BAR();
    }
    if (IN(9)) final_phase(params());
#undef IN
}

extern "C" void kernel_launch(void* const* d_in, const int* in_sizes, int n_in, void* d_out, int out_size, void* d_ws, size_t ws_size, hipStream_t stream) {
    static int grid = 0;
    if (grid == 0) {
        if (n_in != 18 || (size_t)out_size != O_END || ws_size < WS_END) { fprintf(stderr, "kernel_launch: unexpected shapes: n_in %d out %d ws %zu (need %zu)\n", n_in, out_size, ws_size, (size_t)WS_END); grid = -1; return; }
        int dev = 0, cus = 0, per_cu = 0;
        hipGetDevice(&dev); hipDeviceGetAttribute(&cus, hipDeviceAttributeMultiprocessorCount, dev);
        if (hipFuncSetAttribute((const void*)mk_fwd, hipFuncAttributeMaxDynamicSharedMemorySize, LDS_BYTES) != hipSuccess) { fprintf(stderr, "kernel_launch: hipFuncSetAttribute failed\n"); grid = -1; return; }
        if (hipOccupancyMaxActiveBlocksPerMultiprocessor(&per_cu, (const void*)mk_fwd, NTHREADS, LDS_BYTES) != hipSuccess || per_cu < 1) { fprintf(stderr, "kernel_launch: occupancy query says %d\n", per_cu); per_cu = 1; }
        (void)hipGetLastError();
        grid = cus * 1;
        fprintf(stderr, "kernel_launch: grid %d (cus %d, per_cu %d)\n", grid, cus, per_cu);
    }
    if (grid < 0) return;
    if (hipMemsetAsync((char*)d_ws + WS_BAR, 0, 16384, stream) != hipSuccess) { fprintf(stderr, "kernel_launch: memset failed\n"); return; }
    Params p{};
    for (int i = 0; i < 18; ++i) p.in[i] = (const float*)d_in[i];
    p.out = (float*)d_out; p.ws = (unsigned char*)d_ws;
    p.ph_lo = 0; p.ph_hi = 1;
    void* args[] = {&p};
    hipError_t e = hipLaunchCooperativeKernel((const void*)mk_fwd, dim3(grid), dim3(NTHREADS), args, LDS_BYTES, stream);
    if (e != hipSuccess) fprintf(stderr, "kernel_launch: cooperative launch failed: %s (grid %d)\n", hipGetErrorString(e), grid);
}
```
